# Optimizing an MI355X kernel written in HIP

```python
import math
import jax
import jax.numpy as jnp
from jax import lax
import numpy as np

D_MODEL = 2048
BATCH = 1
SEQ = 8192
DEPTH = 4

CHUNK = 64
Q_BLOCK = 128
N_MIXERS = 3
EPS = 1e-6
D_FF = ((8 * D_MODEL) // 3 + 255) // 256 * 256

A_HEADS = D_MODEL // 256
A_HEAD_DIM = 128
A_V_DIM = 2 * A_HEAD_DIM
A_QK = 2 * A_HEADS * A_HEAD_DIM
A_OUT = A_HEADS * A_V_DIM
A_IN = 2 * A_QK + A_OUT

B_HEADS = D_MODEL // 128
B_HEAD_DIM = 128
B_W = B_HEADS * B_HEAD_DIM
B_IN = 4 * B_W + B_HEADS

C_QK_HEADS = D_MODEL // 128
C_V_HEADS = 2 * C_QK_HEADS
C_HEAD_DIM = 128
C_QK = C_QK_HEADS * C_HEAD_DIM
C_VW = C_V_HEADS * C_HEAD_DIM
C_CONV = 4
C_IN = 2 * C_QK + 2 * C_VW + 2 * C_V_HEADS

N_A = (DEPTH + 2) // 3
N_B = (DEPTH + 1) // 3
N_C = DEPTH // 3

kernel_name = 'hybrid_diff_fox_gdn_trunk'


def rms_norm(x, w):
    xf = x.astype(jnp.float32)
    y = xf * lax.rsqrt(jnp.mean(xf * xf, axis=-1, keepdims=True) + EPS)
    return (y * w.astype(jnp.float32)).astype(x.dtype)


def l2_normalize(x):
    xf = x.astype(jnp.float32)
    return xf * lax.rsqrt(jnp.sum(xf * xf, axis=-1, keepdims=True) + EPS)


def to_query_blocks(t):
    b, s = t.shape[:2]
    t = t.reshape((b, s // Q_BLOCK, Q_BLOCK) + t.shape[2:])
    return jnp.moveaxis(t, 1, 0)


def from_query_blocks(t):
    t = jnp.moveaxis(t, 0, 1)
    return t.reshape((t.shape[0], -1) + t.shape[3:])


def diff_lambda_init(layer_idx):
    return 0.8 - 0.6 * math.exp(-0.3 * layer_idx)


def differential_attention(xn, w_in, w_out, lam_q1, lam_k1, lam_q2, lam_k2, sub_norm, lambda_init):
    b, s, _ = xn.shape
    q, k, v = jnp.split(xn @ w_in, [A_QK, 2 * A_QK], axis=-1)
    q = q.reshape(b, s, 2, A_HEADS, A_HEAD_DIM)
    k = k.reshape(b, s, 2, A_HEADS, A_HEAD_DIM)
    v = v.reshape(b, s, A_HEADS, A_V_DIM)
    f32 = jnp.float32
    lam = (jnp.exp(jnp.sum((lam_q1 * lam_k1).astype(f32)))
           - jnp.exp(jnp.sum((lam_q2 * lam_k2).astype(f32))) + lambda_init)
    scale = A_HEAD_DIM ** -0.5
    k_chunk = jnp.arange(s) // CHUNK

    def block(args):
        qb, qpos = args
        sc = jnp.einsum('bqmhd,bkmhd->bmhqk', qb, k, preferred_element_type=f32) * scale
        visible = k_chunk[None, :] <= (qpos // CHUNK)[:, None]
        p = jax.nn.softmax(jnp.where(visible, sc, -jnp.inf), axis=-1)
        a = p[:, 0] - lam * p[:, 1]
        return jnp.einsum('bhqk,bkhe->bqhe', a.astype(v.dtype), v)

    qpos = jnp.arange(s).reshape(-1, Q_BLOCK)
    o = from_query_blocks(lax.map(block, (to_query_blocks(q), qpos)))
    o = rms_norm(o, sub_norm) * (1.0 - lambda_init)
    return o.reshape(b, s, A_OUT) @ w_out


def forgetting_attention(xn, w_in, w_out, forget_bias, q_norm, k_norm):
    b, s, _ = xn.shape
    f32 = jnp.float32
    q, k, v, gate, f_logit = jnp.split(xn @ w_in, [B_W, 2 * B_W, 3 * B_W, 4 * B_W], axis=-1)
    q = rms_norm(q.reshape(b, s, B_HEADS, B_HEAD_DIM), q_norm)
    k = rms_norm(k.reshape(b, s, B_HEADS, B_HEAD_DIM), k_norm)
    v = v.reshape(b, s, B_HEADS, B_HEAD_DIM)
    log_f = jax.nn.log_sigmoid((f_logit + forget_bias).astype(f32))
    cum = jnp.cumsum(log_f, axis=1)
    cum_k = jnp.transpose(cum, (0, 2, 1))
    scale = B_HEAD_DIM ** -0.5
    kpos = jnp.arange(s)

    def block(args):
        qb, cq, qpos = args
        sc = jnp.einsum('bqhd,bkhd->bhqk', qb, k, preferred_element_type=f32) * scale
        sc = sc + jnp.transpose(cq, (0, 2, 1))[..., :, None] - cum_k[..., None, :]
        visible = kpos[None, :] <= qpos[:, None]
        p = jax.nn.softmax(jnp.where(visible, sc, -jnp.inf), axis=-1)
        return jnp.einsum('bhqk,bkhd->bqhd', p.astype(v.dtype), v)

    qpos = jnp.arange(s).reshape(-1, Q_BLOCK)
    o = from_query_blocks(lax.map(block, (to_query_blocks(q), to_query_blocks(cum), qpos)))
    o = o.reshape(b, s, B_W) * jax.nn.sigmoid(gate)
    return o @ w_out


def causal_depthwise_conv(x, w):
    kw = w.shape[0]
    s = x.shape[1]
    xp = jnp.pad(x, ((0, 0), (kw - 1, 0), (0, 0)))
    return sum(xp[:, j:j + s, :] * w[j] for j in range(kw))


def chunked_gated_delta_rule(q, k, v, g, beta):
    b, s, h, dk = q.shape
    dv = v.shape[-1]
    n = s // CHUNK
    out_dtype = v.dtype
    f32 = jnp.float32

    def chunks(t):
        t = jnp.moveaxis(t.astype(f32), 2, 1)
        return t.reshape((b, h, n, CHUNK) + t.shape[3:])

    q, k, v, g, beta = chunks(q), chunks(k), chunks(v), chunks(g), chunks(beta)
    gc = jnp.cumsum(g, axis=-1)
    causal = jnp.tril(jnp.ones((CHUNK, CHUNK), dtype=bool))
    strict = jnp.tril(jnp.ones((CHUNK, CHUNK), dtype=bool), -1)
    decay = jnp.exp(jnp.where(causal, gc[..., :, None] - gc[..., None, :], -jnp.inf))
    kb = k * beta[..., None]
    lower = jnp.where(strict, jnp.einsum('bhnid,bhnjd->bhnij', kb, k) * decay, 0.0)
    tmat = lower + jnp.eye(CHUNK, dtype=f32)
    rhs = jnp.concatenate([v * beta[..., None], kb * jnp.exp(gc)[..., None]], axis=-1)
    sol = lax.linalg.triangular_solve(tmat, rhs, left_side=True, lower=True, unit_diagonal=True)
    u, w = sol[..., :dv], sol[..., dv:]
    intra = jnp.where(causal, jnp.einsum('bhnid,bhnjd->bhnij', q, k) * decay, 0.0)
    g_last = gc[..., -1]
    q_dec = q * jnp.exp(gc)[..., None]
    k_dec = k * jnp.exp(g_last[..., None] - gc)[..., None]
    xs = (jnp.moveaxis(q_dec, 2, 0), jnp.moveaxis(k_dec, 2, 0), jnp.moveaxis(u, 2, 0),
          jnp.moveaxis(w, 2, 0), jnp.moveaxis(intra, 2, 0), jnp.moveaxis(g_last, 2, 0))

    def step(state, inp):
        qd, kd, ui, wi, ai, gl = inp
        v_new = ui - jnp.einsum('bhcd,bhde->bhce', wi, state)
        o = jnp.einsum('bhcd,bhde->bhce', qd, state) + jnp.einsum('bhij,bhje->bhie', ai, v_new)
        state = state * jnp.exp(gl)[..., None, None] + jnp.einsum('bhcd,bhce->bhde', kd, v_new)
        return state, o

    state0 = jnp.zeros((b, h, dk, dv), dtype=f32)
    _, o = lax.scan(step, state0, xs)
    o = jnp.moveaxis(o, 0, 2).reshape(b, h, s, dv)
    return jnp.moveaxis(o, 1, 2).astype(out_dtype)


def gated_deltanet(xn, w_in, w_out, conv_w, a_log, dt_bias, out_norm):
    b, s, _ = xn.shape
    f32 = jnp.float32
    qkv, z, beta_logit, a = jnp.split(
        xn @ w_in, [2 * C_QK + C_VW, 2 * C_QK + 2 * C_VW, 2 * C_QK + 2 * C_VW + C_V_HEADS], axis=-1)
    qkv = jax.nn.silu(causal_depthwise_conv(qkv, conv_w))
    q, k, v = jnp.split(qkv, [C_QK, 2 * C_QK], axis=-1)
    rep = C_V_HEADS // C_QK_HEADS
    q = jnp.repeat(l2_normalize(q.reshape(b, s, C_QK_HEADS, C_HEAD_DIM)), rep, axis=2) * (C_HEAD_DIM ** -0.5)
    k = jnp.repeat(l2_normalize(k.reshape(b, s, C_QK_HEADS, C_HEAD_DIM)), rep, axis=2)
    v = v.reshape(b, s, C_V_HEADS, C_HEAD_DIM)
    beta = jax.nn.sigmoid(beta_logit.astype(f32))
    g = -jnp.exp(a_log.astype(f32)) * jax.nn.softplus((a + dt_bias).astype(f32))
    o = chunked_gated_delta_rule(q, k, v, g, beta)
    o = rms_norm(o, out_norm) * jax.nn.silu(z.reshape(b, s, C_V_HEADS, C_HEAD_DIM))
    return o.reshape(b, s, C_VW) @ w_out


def swiglu(xn, w_gate, w_up, w_down):
    return (jax.nn.silu(xn @ w_gate) * (xn @ w_up)) @ w_down


def setup_inputs(seed: int = 0) -> dict:
    key = jax.random.key(seed)
    ks = jax.random.split(key, 32)
    f32 = jnp.float32

    def nrm(i, shape, scale):
        return jax.random.normal(ks[i], shape, f32) * scale

    def gain(i, shape):
        return 1.0 + 0.05 * jax.random.normal(ks[i], shape, f32)

    dt = jnp.exp(jax.random.uniform(ks[25], (N_C, C_V_HEADS), f32, math.log(1e-3), math.log(1e-1)))
    dt_bias = dt + jnp.log(-jnp.expm1(-dt))
    a_log = jnp.log(jax.random.uniform(ks[26], (N_C, C_V_HEADS), f32, 1.0, 16.0))
    forget_bias = jax.random.uniform(ks[27], (N_B, B_HEADS), f32, 1.0, 4.0)
    return {
        'x': nrm(0, (BATCH, SEQ, D_MODEL), 1.0),
        'mix_norm': gain(1, (DEPTH, D_MODEL)),
        'ffn_norm': gain(2, (DEPTH, D_MODEL)),
        'final_norm': gain(3, (D_MODEL,)),
        'a_w_in': nrm(4, (N_A, D_MODEL, A_IN), D_MODEL ** -0.5),
        'a_w_out': nrm(5, (N_A, A_OUT, D_MODEL), A_OUT ** -0.5),
        'a_lam_q1': nrm(6, (N_A, A_HEAD_DIM), 0.1),
        'a_lam_k1': nrm(7, (N_A, A_HEAD_DIM), 0.1),
        'a_lam_q2': nrm(8, (N_A, A_HEAD_DIM), 0.1),
        'a_lam_k2': nrm(9, (N_A, A_HEAD_DIM), 0.1),
        'a_sub_norm': gain(10, (N_A, A_V_DIM)),
        'b_w_in': nrm(11, (N_B, D_MODEL, B_IN), D_MODEL ** -0.5),
        'b_w_out': nrm(12, (N_B, B_W, D_MODEL), B_W ** -0.5),
        'b_forget_bias': forget_bias,
        'b_q_norm': gain(13, (N_B, B_HEAD_DIM)),
        'b_k_norm': gain(14, (N_B, B_HEAD_DIM)),
        'c_w_in': nrm(15, (N_C, D_MODEL, C_IN), D_MODEL ** -0.5),
        'c_w_out': nrm(16, (N_C, C_VW, D_MODEL), C_VW ** -0.5),
        'c_conv_w': nrm(17, (N_C, C_CONV, 2 * C_QK + C_VW), C_CONV ** -0.5),
        'c_a_log': a_log,
        'c_dt_bias': dt_bias,
        'c_out_norm': gain(18, (N_C, C_HEAD_DIM)),
        'ffn_w_gate': nrm(19, (DEPTH, D_MODEL, D_FF), D_MODEL ** -0.5),
        'ffn_w_up': nrm(20, (DEPTH, D_MODEL, D_FF), D_MODEL ** -0.5),
        'ffn_w_down': nrm(21, (DEPTH, D_FF, D_MODEL), D_FF ** -0.5),
    }


def reference(x, mix_norm, ffn_norm, final_norm, a_w_in, a_w_out, a_lam_q1, a_lam_k1, a_lam_q2, a_lam_k2,
              a_sub_norm, b_w_in, b_w_out, b_forget_bias, b_q_norm, b_k_norm, c_w_in, c_w_out, c_conv_w,
              c_a_log, c_dt_bias, c_out_norm, ffn_w_gate, ffn_w_up, ffn_w_down):
    h = x
    for i in range(DEPTH):
        slot = i // N_MIXERS
        xn = rms_norm(h, mix_norm[i])
        if i % N_MIXERS == 0:
            mixed = differential_attention(xn, a_w_in[slot], a_w_out[slot], a_lam_q1[slot], a_lam_k1[slot],
                                           a_lam_q2[slot], a_lam_k2[slot], a_sub_norm[slot], diff_lambda_init(i))
        elif i % N_MIXERS == 1:
            mixed = forgetting_attention(xn, b_w_in[slot], b_w_out[slot], b_forget_bias[slot],
                                         b_q_norm[slot], b_k_norm[slot])
        else:
            mixed = gated_deltanet(xn, c_w_in[slot], c_w_out[slot], c_conv_w[slot], c_a_log[slot],
                                   c_dt_bias[slot], c_out_norm[slot])
        h = h + mixed.astype(h.dtype)
        h = h + swiglu(rms_norm(h, ffn_norm[i]), ffn_w_gate[i], ffn_w_up[i], ffn_w_down[i]).astype(h.dtype)
    return rms_norm(h, final_norm)
```

```cpp
#include <hip/hip_runtime.h>
#include <hip/hip_cooperative_groups.h>
#include <cstdio>
#include <cstdint>
#include <cmath>
namespace cg = cooperative_groups;
__device__ __forceinline__ int lane_asm() { int l; asm volatile("v_mbcnt_lo_u32_b32 %0, -1, 0\n\tv_mbcnt_hi_u32_b32 %0, -1, %0" : "=v"(l)); return l; }
__device__ __forceinline__ int tidw(int wv) { return wv * 64 + lane_asm(); }
__device__ __forceinline__ size_t opq(size_t v) { asm volatile("" : "+s"(v)); return v; }
__device__ __forceinline__ float shx(float v, int o) { return __builtin_bit_cast(float, __builtin_amdgcn_ds_bpermute((lane_asm() ^ o) << 2, __builtin_bit_cast(int, v))); }
__device__ __forceinline__ float shup(float v, int o) { const int l = lane_asm(); return __builtin_bit_cast(float, __builtin_amdgcn_ds_bpermute((l >= o ? l - o : l) << 2, __builtin_bit_cast(int, v))); }
__device__ __forceinline__ int opq_i(int v) { asm volatile("" : "+s"(v)); return v; }
namespace pg8 {
#define PG8_LAS __attribute__((address_space(3)))
typedef unsigned short bf16_t;
typedef short bf16x8 __attribute__((ext_vector_type(8)));
typedef float f32x4 __attribute__((ext_vector_type(4)));
typedef unsigned u32x4 __attribute__((ext_vector_type(4)));
constexpr int BM = 256, BK = 64, HALF = 128, HTB = HALF * BK * 2  , STAGE_BYTES = 8 * HTB, NXCD = 8, WGM = 8;

__host__ __device__ __forceinline__ int lds_byte(int r, int c) { const int st = (r >> 4) * 2 + (c >> 5), rr = r & 15, cc = c & 31, ob = rr * 64 + cc * 2; return st * 1024 + (ob ^ (((ob >> 9) & 1) << 5)); }
__host__ __device__ __forceinline__ void stage_rc(int b, int& R, int& C) { const int st = b / 1024, sb = b % 1024, swz = sb ^ (((sb >> 9) & 1) << 5); R = (st >> 1) * 16 + swz / 64; C = (st & 1) * 32 + (swz % 64) / 2; }
__host__ __device__ __forceinline__ int perm32(int rho) { const int n = rho >> 4, i = rho & 15; return 8 * (i >> 2) + 4 * n + (i & 3); }

struct Unit { int pm, pn, ks; };
struct Gemm { const bf16_t* A; const bf16_t* Bt; int M, N, K; int kt; };

struct StaticOrder {
    int nM, nN, nwg, G, c;
    __host__ __device__ void init(int M, int N, int G_, int c_) { nM = M / BM; nN = N / BM; nwg = nM * nN; G = G_; c = c_; }
    __host__ __device__ bool next(int i, Unit& u) const {
        const long L = (long)i * G + c; if (L >= nwg) return false;
        int wgid = (int)L; { const int q = nwg / NXCD, r = nwg % NXCD, xcd = wgid % NXCD, off = wgid / NXCD; wgid = (xcd < r ? xcd * (q + 1) : r * (q + 1) + (xcd - r) * q) + off; }
        const int nig = WGM * nN, gid = wgid / nig, fm = gid * WGM, gsz = (nM - fm) < WGM ? (nM - fm) : WGM;
        u.pm = fm + ((wgid % nig) % gsz); u.pn = (wgid % nig) / gsz; u.ks = 0; return true;
    }
    __device__ __forceinline__ void a_ready(const Unit&) const {}
    __device__ __forceinline__ void done(const Unit&) const {}
};
struct SplitKOrder {
    int nunits, G, c, SK, pn;
    __host__ __device__ void init(int M, int SK_, int pn_, int G_, int c_) { nunits = (M / BM) * SK_; G = G_; c = c_; SK = SK_; pn = pn_; }
    __host__ __device__ bool next(int i, Unit& u) const { const int L = i * G + c; if (L >= nunits) return false; u.pm = L / SK; u.ks = L % SK; u.pn = pn; return true; }
    __device__ __forceinline__ void a_ready(const Unit&) const {}
    __device__ __forceinline__ void done(const Unit&) const {}
};


__device__ __forceinline__ unsigned cvt_pk_bf16(float lo, float hi) { unsigned r; asm volatile("v_cvt_pk_bf16_f32 %0, %1, %2" : "=v"(r) : "v"(lo), "v"(hi)); return r; }
typedef unsigned u32x2v __attribute__((ext_vector_type(2)));
struct EpiStore {
    static constexpr bool PERM = true, AFTER_DRAIN = false;
    bf16_t* O0; int ld0; bf16_t* O1; int ld1; int split;
    float* XF; int ldx; int xsplit;
    int qcols; float qscale;
    __device__ __forceinline__ void operator()(const f32x4 (&acc)[2][2][4][2], const Unit& u, int wr, int wc, int fr, int fq) const {
        const int row0 = u.pm * BM + wr * 64 + fr; int colt = u.pn * BM;
        if (colt >= xsplit) {
#pragma unroll
            for (int ai = 0; ai < 2; ++ai)
#pragma unroll
                for (int m = 0; m < 4; ++m) { const size_t row = (size_t)(row0 + ai * HALF + m * 16);
#pragma unroll
                    for (int n = 0; n < 2; ++n) { const int c = wc * 32 + 8 * fq + 4 * n; if (c < ldx) *(f32x4*)(XF + row * ldx + c) = acc[ai][0][m][n]; } }
            return;
        }
        const float sc = (colt < qcols) ? qscale : 1.f;
        bf16_t* base = O0; int ld = ld0; if (colt >= split) { base = O1; ld = ld1; colt -= split; }
        const int col0 = colt + wc * 32 + 8 * fq;
#pragma unroll
        for (int ai = 0; ai < 2; ++ai)
#pragma unroll
            for (int m = 0; m < 4; ++m) { bf16_t* rowp = base + (size_t)(row0 + ai * HALF + m * 16) * ld + col0;
#pragma unroll
                for (int bj = 0; bj < 2; ++bj) { const f32x4 v0 = acc[ai][bj][m][0] * sc, v1 = acc[ai][bj][m][1] * sc;
                    u32x4 w; w.x = cvt_pk_bf16(v0[0], v0[1]); w.y = cvt_pk_bf16(v0[2], v0[3]); w.z = cvt_pk_bf16(v1[0], v1[1]); w.w = cvt_pk_bf16(v1[2], v1[3]);
                    *(u32x4*)(rowp + bj * HALF) = w; } }
    }
};
__device__ __forceinline__ float silu_f(float x) { return x * __builtin_amdgcn_rcpf(1.f + __expf(-x)); }
struct EpiSwiglu {
    static constexpr bool PERM = true, AFTER_DRAIN = false;
    bf16_t* O; int ld;
    __device__ __forceinline__ void operator()(const f32x4 (&acc)[2][2][4][2], const Unit& u, int wr, int wc, int fr, int fq) const {
        const int row0 = u.pm * BM + wr * 64 + fr; const int col0 = u.pn * HALF + wc * 32 + 8 * fq;
#pragma unroll
        for (int ai = 0; ai < 2; ++ai)
#pragma unroll
            for (int m = 0; m < 4; ++m) { bf16_t* rowp = O + (size_t)(row0 + ai * HALF + m * 16) * ld + col0;
                const f32x4 g0 = acc[ai][0][m][0], g1 = acc[ai][0][m][1], u0 = acc[ai][1][m][0], u1 = acc[ai][1][m][1];
                u32x4 w; w.x = cvt_pk_bf16(silu_f(g0[0]) * u0[0], silu_f(g0[1]) * u0[1]); w.y = cvt_pk_bf16(silu_f(g0[2]) * u0[2], silu_f(g0[3]) * u0[3]);
                w.z = cvt_pk_bf16(silu_f(g1[0]) * u1[0], silu_f(g1[1]) * u1[1]); w.w = cvt_pk_bf16(silu_f(g1[2]) * u1[2], silu_f(g1[3]) * u1[3]);
                *(u32x4*)rowp = w; }
    }
};
struct EpiRes {
    static constexpr bool PERM = false, AFTER_DRAIN = false;
    const float* base; float* out; int ld;
    __device__ __forceinline__ void operator()(const f32x4 (&acc)[2][2][4][2], const Unit& u, int wr, int wc, int fr, int fq) const {
        const int row0 = u.pm * BM + wr * 64 + fr; const int col0 = u.pn * BM + wc * 32 + 4 * fq;
#pragma unroll
        for (int ai = 0; ai < 2; ++ai)
#pragma unroll
            for (int m = 0; m < 4; ++m) { const size_t off = (size_t)(row0 + ai * HALF + m * 16) * ld + col0;
#pragma unroll
                for (int bj = 0; bj < 2; ++bj)
#pragma unroll
                    for (int n = 0; n < 2; ++n) { const f32x4 b = *(const f32x4*)(base + off + bj * HALF + n * 16); *(f32x4*)(out + off + bj * HALF + n * 16) = b + acc[ai][bj][m][n]; } }
    }
};

struct EpiXF {
    static constexpr bool PERM = true, AFTER_DRAIN = false;
    float* XF; int ldx; size_t slab; int tr;
    __device__ __forceinline__ void operator()(const f32x4 (&acc)[2][2][4][2], const Unit& u, int wr, int wc, int fr, int fq) const {
        const int row0 = u.pm * BM + wr * 64 + fr; float* base = XF + (size_t)u.ks * slab;
#pragma unroll
        for (int ai = 0; ai < 2; ++ai)
#pragma unroll
            for (int m = 0; m < 4; ++m) { const size_t row = (size_t)(row0 + ai * HALF + m * 16);
#pragma unroll
                for (int n = 0; n < 2; ++n) { const int c = wc * 32 + 8 * fq + 4 * n;
                    if (c < ldx) { if (tr) {
#pragma unroll
                            for (int q = 0; q < 4; ++q) base[(size_t)(c + q) * 8192 + row] = acc[ai][0][m][n][q]; }
                        else *(f32x4*)(base + row * ldx + c) = acc[ai][0][m][n]; } } }
    }
};
template <class Epi, class Sched, bool ALIGN_EPI = false, bool SP2 = false>
__device__ __forceinline__ void gemm_phase(PG8_LAS unsigned char* lds, const Gemm g, const Sched& S, const Epi& E, int wv) {
    const int tid = tidw(wv), wid = wv, lane = tid & 63, wr = wid >> 2, wc = wid & 3, fr = lane & 15, fq = lane >> 4;
    const int K = g.K, nt = g.kt; const size_t ksl = (size_t)g.kt * BK * 2;
    unsigned voffA[2], voffB[2];
#pragma unroll
    for (int i = 0; i < 2; ++i) { int R, C; stage_rc(tid * 16 + i * 8192, R, C); const int Rb = Epi::PERM ? ((R & ~31) + perm32(R & 31)) : R;
        voffA[i] = (unsigned)(R * K + C) * 2u; voffB[i] = (unsigned)(Rb * K + C) * 2u; }
    const size_t kstep = (size_t)(BK * 2);
    const size_t hstep = (size_t)HALF * K * 2;
    const size_t tstep = 2 * hstep;
    const unsigned ldsw = (unsigned)wid * 1024u;
    const int aoff = lds_byte(wr * 64 + fr, fq * 8), boff = lds_byte(wc * 32 + fr, fq * 8);
#define PG8_SA(b, h) (((b) * 2 + (h)) * HTB)
#define PG8_SB(b, h) ((4 + (b) * 2 + (h)) * HTB)
#define PG8_STAGE(bufoff, gbase, voff) do { _Pragma("unroll") for (int _i = 0; _i < 2; ++_i) \
        __builtin_amdgcn_global_load_lds((const unsigned*)((const char*)(gbase) + (voff)[_i]), (PG8_LAS unsigned*)(lds + (bufoff) + ldsw + _i * 8192), 16, 0, 0); } while (0)
#define PG8_LDA(dst, b, h) do { _Pragma("unroll") for (int m = 0; m < 4; ++m) _Pragma("unroll") for (int k = 0; k < 2; ++k) dst[m][k] = *(const PG8_LAS bf16x8*)(lds + PG8_SA(b, h) + aoff + m * 2048 + k * 1024); } while (0)
#define PG8_LDB(dst, b, h) do { _Pragma("unroll") for (int n = 0; n < 2; ++n) _Pragma("unroll") for (int k = 0; k < 2; ++k) dst[n][k] = *(const PG8_LAS bf16x8*)(lds + PG8_SB(b, h) + boff + n * 2048 + k * 1024); } while (0)
#define PG8_MMA(ai, bj, At, Bt) do { __builtin_amdgcn_s_setprio(1); _Pragma("unroll") for (int m = 0; m < 4; ++m) _Pragma("unroll") for (int n = 0; n < 2; ++n) _Pragma("unroll") for (int k = 0; k < 2; ++k) \
        acc[ai][bj][m][n] = __builtin_amdgcn_mfma_f32_16x16x32_bf16(Bt[n][k], At[m][k], acc[ai][bj][m][n], 0, 0, 0); __builtin_amdgcn_s_setprio(0); } while (0)
#define PG8_WAIT_V(n) asm volatile("s_waitcnt vmcnt(" #n ")" ::: "memory")
#define PG8_WAIT_L(n) asm volatile("s_waitcnt lgkmcnt(" #n ")" ::: "memory")
#define PG8_BAR __builtin_amdgcn_s_barrier()
#define PG8_SCHED __builtin_amdgcn_sched_barrier(0)
    Unit cur, nxt; int ui = 0;
    if (!S.next(0, cur)) return;
    f32x4 acc[2][2][4][2];
#pragma unroll
    for (int a = 0; a < 2; ++a)
#pragma unroll
        for (int b = 0; b < 2; ++b)
#pragma unroll
            for (int m = 0; m < 4; ++m)
#pragma unroll
                for (int n = 0; n < 2; ++n) acc[a][b][m][n] = (f32x4){0.f, 0.f, 0.f, 0.f};
    bf16x8 At[4][2], B0[2][2], B1[2][2];
    const char* cA = (const char*)g.A + (size_t)cur.pm * tstep + (size_t)cur.ks * ksl; const char* cB = (const char*)g.Bt + (size_t)cur.pn * tstep + (size_t)cur.ks * ksl;
    S.a_ready(cur);
    if constexpr (SP2) {
        PG8_STAGE(PG8_SB(0, 0), cB, voffB); PG8_STAGE(PG8_SB(0, 1), cB + hstep, voffB); PG8_STAGE(PG8_SA(0, 0), cA, voffA); PG8_STAGE(PG8_SA(0, 1), cA + hstep, voffA);
        if (wr == 1) PG8_BAR;
        PG8_WAIT_V(2); PG8_BAR;
        PG8_STAGE(PG8_SB(1, 0), cB + kstep, voffB); PG8_STAGE(PG8_SA(1, 0), cA + kstep, voffA); PG8_STAGE(PG8_SB(1, 1), cB + hstep + kstep, voffB);
        PG8_WAIT_V(6); PG8_BAR;
    } else {
        PG8_STAGE(PG8_SB(0, 0), cB, voffB); PG8_STAGE(PG8_SA(0, 0), cA, voffA); PG8_STAGE(PG8_SB(0, 1), cB + hstep, voffB); PG8_STAGE(PG8_SA(0, 1), cA + hstep, voffA);
        if (wr == 1) PG8_BAR;
        PG8_WAIT_V(4); PG8_BAR;
        PG8_STAGE(PG8_SB(1, 0), cB + kstep, voffB); PG8_STAGE(PG8_SA(1, 0), cA + kstep, voffA); PG8_STAGE(PG8_SB(1, 1), cB + hstep + kstep, voffB);
        PG8_WAIT_V(6); PG8_BAR;
    }
    for (;;) {
        const bool has_next = S.next(ui + 1, nxt);
        const char* nA = has_next ? (const char*)g.A + (size_t)nxt.pm * tstep + (size_t)nxt.ks * ksl : cA; const char* nB = has_next ? (const char*)g.Bt + (size_t)nxt.pn * tstep + (size_t)nxt.ks * ksl : cB;
        for (int t = 0; t < nt; t += 2) {
            const bool last = (t == nt - 2);
            const char* a1 = cA + (size_t)(t + 1) * kstep;
            const char* a2 = last ? nA : cA + (size_t)(t + 2) * kstep; const char* b2 = last ? nB : cB + (size_t)(t + 2) * kstep;
            const char* a3 = a2 + kstep; const char* b3 = b2 + kstep;
            if (last && has_next) S.a_ready(nxt);
            if constexpr (SP2) {
            PG8_LDB(B0, 0, 0); PG8_LDB(B1, 0, 1); PG8_SCHED; PG8_LDA(At, 0, 0); PG8_STAGE(PG8_SA(1, 1), a1 + hstep, voffA);
            PG8_WAIT_V(8); PG8_WAIT_L(0); PG8_BAR; PG8_MMA(0, 0, At, B0); PG8_MMA(0, 1, At, B1); PG8_BAR; PG8_SCHED;
            PG8_LDA(At, 0, 1); PG8_STAGE(PG8_SB(0, 0), b2, voffB); PG8_STAGE(PG8_SB(0, 1), b2 + hstep, voffB); PG8_STAGE(PG8_SA(0, 0), a2, voffA);
            PG8_WAIT_V(8); PG8_WAIT_L(0); PG8_BAR; PG8_MMA(1, 0, At, B0); PG8_MMA(1, 1, At, B1); PG8_BAR; PG8_SCHED;
            PG8_LDB(B0, 1, 0); PG8_LDB(B1, 1, 1); PG8_SCHED; PG8_LDA(At, 1, 0); PG8_STAGE(PG8_SA(0, 1), a2 + hstep, voffA);
            PG8_WAIT_V(8); PG8_WAIT_L(0); PG8_BAR; PG8_MMA(0, 0, At, B0); PG8_MMA(0, 1, At, B1); PG8_BAR; PG8_SCHED;
            PG8_LDA(At, 1, 1); PG8_STAGE(PG8_SB(1, 0), b3, voffB); PG8_STAGE(PG8_SB(1, 1), b3 + hstep, voffB); PG8_STAGE(PG8_SA(1, 0), a3, voffA);
            PG8_WAIT_V(8); PG8_WAIT_L(0); PG8_BAR; PG8_MMA(1, 0, At, B0); PG8_MMA(1, 1, At, B1); PG8_BAR; PG8_SCHED;
            } else {
            PG8_LDB(B0, 0, 0); PG8_SCHED; PG8_LDA(At, 0, 0); PG8_STAGE(PG8_SA(1, 1), a1 + hstep, voffA);
            PG8_WAIT_L(8); PG8_BAR; PG8_WAIT_L(0); PG8_MMA(0, 0, At, B0); PG8_BAR; PG8_SCHED;
            PG8_LDB(B1, 0, 1); PG8_STAGE(PG8_SB(0, 0), b2, voffB);
            PG8_BAR; PG8_WAIT_L(0); PG8_MMA(0, 1, At, B1); PG8_BAR;
            PG8_LDA(At, 0, 1); PG8_STAGE(PG8_SA(0, 0), a2, voffA);
            PG8_BAR; PG8_WAIT_L(0); PG8_MMA(1, 0, At, B0); PG8_BAR; PG8_SCHED;
            PG8_STAGE(PG8_SB(0, 1), b2 + hstep, voffB);
            PG8_WAIT_V(6); PG8_BAR; PG8_MMA(1, 1, At, B1); PG8_BAR;
            PG8_LDB(B0, 1, 0); PG8_SCHED; PG8_LDA(At, 1, 0); PG8_STAGE(PG8_SA(0, 1), a2 + hstep, voffA);
            PG8_WAIT_L(8); PG8_BAR; PG8_WAIT_L(0); PG8_MMA(0, 0, At, B0); PG8_BAR; PG8_SCHED;
            PG8_LDB(B1, 1, 1); PG8_STAGE(PG8_SB(1, 0), b3, voffB);
            PG8_BAR; PG8_WAIT_L(0); PG8_MMA(0, 1, At, B1); PG8_BAR;
            PG8_LDA(At, 1, 1); PG8_STAGE(PG8_SA(1, 0), a3, voffA);
            PG8_BAR; PG8_WAIT_L(0); PG8_MMA(1, 0, At, B0); PG8_BAR; PG8_SCHED;
            PG8_STAGE(PG8_SB(1, 1), b3 + hstep, voffB);
            PG8_WAIT_V(6); PG8_BAR; PG8_MMA(1, 1, At, B1); PG8_BAR;
            }
        }
        if constexpr (ALIGN_EPI) { if (wr == 0) PG8_BAR; }
        if constexpr (!Epi::AFTER_DRAIN) { E(acc, cur, wr, wc, fr, fq); S.done(cur); }
        if (!has_next) break;
#pragma unroll
        for (int a = 0; a < 2; ++a)
#pragma unroll
            for (int b = 0; b < 2; ++b)
#pragma unroll
                for (int m = 0; m < 4; ++m)
#pragma unroll
                    for (int n = 0; n < 2; ++n) acc[a][b][m][n] = (f32x4){0.f, 0.f, 0.f, 0.f};
        cur = nxt; cA = nA; cB = nB; ++ui;
        if constexpr (ALIGN_EPI) { if (wr == 1) PG8_BAR; }
    }
    PG8_WAIT_V(0);
    if constexpr (!ALIGN_EPI) { if (wr == 0) PG8_BAR; }
    PG8_BAR;
    if constexpr (Epi::AFTER_DRAIN) { E.fused(acc, cur, wr, wc, fr, fq, lds, wid, lane); S.done(cur); }
#undef PG8_SA
#undef PG8_SB
#undef PG8_STAGE
#undef PG8_LDA
#undef PG8_LDB
#undef PG8_MMA
#undef PG8_WAIT_V
#undef PG8_WAIT_L
#undef PG8_BAR
#undef PG8_SCHED
}
}

#define LAS __attribute__((address_space(3)))
typedef unsigned short bf16_t;
typedef short bf16x8 __attribute__((ext_vector_type(8)));
typedef short s16x4 __attribute__((ext_vector_type(4)));
typedef float f32x4 __attribute__((ext_vector_type(4)));
typedef float f32x2 __attribute__((ext_vector_type(2)));
typedef float f32x16 __attribute__((ext_vector_type(16)));
typedef unsigned u32x4 __attribute__((ext_vector_type(4)));
typedef unsigned u32x2 __attribute__((ext_vector_type(2)));

constexpr int M = 8192, DM = 2048, FF = 5632;
constexpr float EPS = 1e-6f;
constexpr float LOG2E = 1.4426950408889634f;
constexpr float QSCALE = 0.08838834764831845f * LOG2E;
constexpr int NTHREADS = 512, NWAVES = 8;

typedef __bf16 bf16x2_t __attribute__((ext_vector_type(2)));
__device__ __forceinline__ unsigned cvtpk(float lo, float hi) { f32x2 v = {lo, hi}; bf16x2_t b = __builtin_convertvector(v, bf16x2_t); return __builtin_bit_cast(unsigned, b); }
__device__ __forceinline__ float bf2f(unsigned short v) { return __uint_as_float((unsigned)v << 16); }
__device__ __forceinline__ float bflo(unsigned w) { return __uint_as_float(w << 16); }
__device__ __forceinline__ float bfhi(unsigned w) { return __uint_as_float(w & 0xffff0000u); }
__device__ __forceinline__ unsigned short f2bf(float f) { return (unsigned short)(cvtpk(f, 0.f) & 0xffffu); }
__device__ __forceinline__ float wave_sum(float v) {
#pragma unroll
    for (int o = 1; o < 64; o <<= 1) v += shx(v, o);
    return v;
}
__device__ __forceinline__ float sigmoid_f(float x) { return __builtin_amdgcn_rcpf(1.f + __expf(-x)); }
__device__ __forceinline__ float silu_m(float x) { return x * __builtin_amdgcn_rcpf(1.f + __expf(-x)); }
__device__ __forceinline__ float softplus_f(float x) { return fmaxf(x, 0.f) + log1pf(__expf(-fabsf(x))); }
__device__ __forceinline__ float logsigmoid_f(float x) { return fminf(x, 0.f) - log1pf(__expf(-fabsf(x))); }

struct CvtItem { f32x4 v[16]; };
__device__ __forceinline__ void cvt_load(CvtItem& it, const float* __restrict__ W, int ldw, int c0, int nvalid, int k0, int lane) {
    const int cc = 4 * (lane & 15); const float* wp = W + (size_t)(k0 + (lane >> 4)) * ldw + c0 + cc;
#pragma unroll
    for (int i = 0; i < 16; ++i) { it.v[i] = (f32x4){0.f, 0.f, 0.f, 0.f}; if (cc < nvalid) it.v[i] = __builtin_nontemporal_load((const f32x4*)(wp + (size_t)(4 * i) * ldw)); }
}
__device__ __forceinline__ void cvt_finish(const CvtItem& it, int nvalid, int k0, bf16_t* __restrict__ WT, int K, int drow0, LAS float* scr, int lane) {
    const int cc = 4 * (lane & 15);
#pragma unroll
    for (int i = 0; i < 16; ++i) { const int kk = 4 * i + (lane >> 4);
        LAS float* s = scr + kk * 65 + cc; s[0] = it.v[i][0]; s[1] = it.v[i][1]; s[2] = it.v[i][2]; s[3] = it.v[i][3]; }
    asm volatile("s_waitcnt lgkmcnt(0)" ::: "memory");
    const int c = lane & 7;
#pragma unroll
    for (int j = 0; j < 8; ++j) { const int n = 8 * j + (lane >> 3); const LAS float* s = scr + (8 * c) * 65 + n;
        u32x4 o; o.x = cvtpk(s[0], s[65]); o.y = cvtpk(s[2 * 65], s[3 * 65]); o.z = cvtpk(s[4 * 65], s[5 * 65]); o.w = cvtpk(s[6 * 65], s[7 * 65]);
        if (n < nvalid) *(u32x4*)(WT + (size_t)(drow0 + n) * K + k0 + 8 * c) = o; }
    asm volatile("s_waitcnt lgkmcnt(0)" ::: "memory");
}
__device__ __forceinline__ void cvt_matrix(const float* W, int ldw, int col0, int ncols, int K, bf16_t* WT, int dmode, int drow_off, LAS float* scr, int gw, int ngw, int lane) {
    const int nb = (ncols + 63) >> 6, items = (K >> 6) * nb;
#define CVT_DECODE(it_) const int kb = (it_) / nb, nbk = (it_) - kb * nb, n0 = nbk << 6; const int nvalid = (ncols - n0) < 64 ? (ncols - n0) : 64; \
        const int drow0 = dmode == 0 ? drow_off + n0 : ((n0 >> 7) << 8) + (n0 & 127) + (dmode == 2 ? 128 : 0);
    CvtItem A, B;
    int it = gw;
    if (it < items) { CVT_DECODE(it) (void)drow0; cvt_load(A, W, ldw, col0 + n0, nvalid, kb << 6, lane); }
    for (; it < items; it += 2 * ngw) {
        if (it + ngw < items) { CVT_DECODE(it + ngw) (void)drow0; cvt_load(B, W, ldw, col0 + n0, nvalid, kb << 6, lane); }
        { CVT_DECODE(it) cvt_finish(A, nvalid, kb << 6, WT, K, drow0, scr, lane); }
        if (it + 2 * ngw < items) { CVT_DECODE(it + 2 * ngw) (void)drow0; cvt_load(A, W, ldw, col0 + n0, nvalid, kb << 6, lane); }
        if (it + ngw < items) { CVT_DECODE(it + ngw) cvt_finish(B, nvalid, kb << 6, WT, K, drow0, scr, lane); }
    }
#undef CVT_DECODE
}

template <bool OUTF, bool COPY = false> __device__ __forceinline__ void norm_rows(const float* __restrict__ X, const float* __restrict__ w, bf16_t* __restrict__ Ob, float* __restrict__ Of, int gw, int ngw, int lane, float* __restrict__ Cp = nullptr) {
    for (int m0 = gw * 4; m0 < M; m0 += ngw * 4) {
        f32x4 v[4][8]; float s[4] = {0.f, 0.f, 0.f, 0.f};
#pragma unroll
        for (int q = 0; q < 4; ++q) { const f32x4* xr = (const f32x4*)(X + (size_t)(m0 + q) * DM) + lane;
#pragma unroll
            for (int j = 0; j < 8; ++j) v[q][j] = xr[64 * j]; }
#pragma unroll
        for (int q = 0; q < 4; ++q) { const int m = m0 + q;
#pragma unroll
            for (int j = 0; j < 8; ++j) { s[q] += (v[q][j][0] * v[q][j][0] + v[q][j][1] * v[q][j][1]) + (v[q][j][2] * v[q][j][2] + v[q][j][3] * v[q][j][3]);
                if (COPY) *((f32x4*)(Cp + (size_t)m * DM) + lane + 64 * j) = v[q][j]; }
            const float r = rsqrtf(wave_sum(s[q]) * (1.f / DM) + EPS);
#pragma unroll
            for (int j = 0; j < 8; ++j) { const f32x4 ww = *((const f32x4*)w + lane + 64 * j); const f32x4 o = v[q][j] * r * ww;
                if (OUTF) *((f32x4*)(Of + (size_t)m * DM) + lane + 64 * j) = o;
                else { u32x2 p; p.x = cvtpk(o[0], o[1]); p.y = cvtpk(o[2], o[3]); *((u32x2*)(Ob + (size_t)m * DM) + lane + 64 * j) = p; } } }
    }
}

namespace att {
constexpr int NW = 8, QBLK = 32, KVBLK = 64;
constexpr int SHM_V = 16384, SHM_K = 16384;
constexpr int OFF_K = 2 * SHM_V, OFF_WS = OFF_K + 2 * SHM_K, OFF_CK = OFF_WS + NW * 64 * 4, LDS_ATT = OFF_CK + 2 * 256;
constexpr float THR = 8.f;
#define KSWZ(row, colB) ((row) * 256 + ((colB) ^ (((row) & 7) << 4)))
#define SBAR() __builtin_amdgcn_sched_barrier(0)
__device__ __forceinline__ int crow(int r, int hi) { return (r & 3) + 8 * (r >> 2) + 4 * hi; }
template <int MODE> __device__ __forceinline__ void maskp(f32x16& p0, f32x16& p1, int t, int NT, int qb, int wid, int qrel, int hi) {
    const float NEG = -INFINITY;
    if (MODE == 0) { if (t > 4 * qb + (wid >> 1)) {
#pragma unroll
            for (int r = 0; r < 16; ++r) { p0[r] = NEG; p1[r] = NEG; } } }
    else { if (t >= NT - 4) { const int d = qrel - (64 * (t - (NT - 4)) + 4 * hi);
#pragma unroll
            for (int r = 0; r < 16; ++r) { const int c = (r & 3) + 8 * (r >> 2); p0[r] = (c > d) ? NEG : p0[r]; p1[r] = (c + 32 > d) ? NEG : p1[r]; } } }
}
__device__ __forceinline__ void partialSM(f32x16& p0, f32x16& p1, float& m_reg, float& alpha) {
    float pmax = p0[0];
#pragma unroll
    for (int r = 1; r < 16; ++r) pmax = fmaxf(pmax, p0[r]);
#pragma unroll
    for (int r = 0; r < 16; ++r) pmax = fmaxf(pmax, p1[r]);
    { auto rr = __builtin_amdgcn_permlane32_swap(__float_as_uint(pmax), __float_as_uint(pmax), false, false);
      pmax = fmaxf(__uint_as_float(rr[0]), __uint_as_float(rr[1])); }
    float mn;
    if (__builtin_expect(__all(pmax - m_reg <= THR), 1)) { mn = m_reg; alpha = 1.f; }
    else { mn = fmaxf(m_reg, pmax); alpha = __builtin_amdgcn_exp2f(m_reg - mn); m_reg = mn; }
#pragma unroll
    for (int r = 0; r < 16; ++r) p0[r] = p0[r] - mn;
#pragma unroll
    for (int r = 0; r < 16; ++r) p1[r] = p1[r] - mn;
#pragma unroll
    for (int r = 0; r < 16; ++r) p0[r] = __builtin_amdgcn_exp2f(p0[r]);
}
__device__ __forceinline__ void finishSM(f32x16& p0, f32x16& p1, float alpha, float& l_reg, bf16x8& pa0, bf16x8& pa1, bf16x8& pa2, bf16x8& pa3) {
#pragma unroll
    for (int r = 0; r < 16; ++r) p1[r] = __builtin_amdgcn_exp2f(p1[r]);
    float ps = 0;
#pragma unroll
    for (int r = 0; r < 16; ++r) ps += p0[r];
#pragma unroll
    for (int r = 0; r < 16; ++r) ps += p1[r];
    { auto rr = __builtin_amdgcn_permlane32_swap(__float_as_uint(ps), __float_as_uint(ps), false, false);
      ps = __uint_as_float(rr[0]) + __uint_as_float(rr[1]); }
    l_reg = l_reg * alpha + ps;
#define PK4(P, BASE, OUT) do { unsigned a0 = cvtpk(P[BASE + 0], P[BASE + 1]), a1 = cvtpk(P[BASE + 2], P[BASE + 3]);   \
    unsigned b0 = cvtpk(P[BASE + 4], P[BASE + 5]), b1 = cvtpk(P[BASE + 6], P[BASE + 7]);                              \
    auto r0 = __builtin_amdgcn_permlane32_swap(a0, b0, false, false); auto r1 = __builtin_amdgcn_permlane32_swap(a1, b1, false, false); \
    u32x4 w = {r0[0], r1[0], r0[1], r1[1]}; OUT = *reinterpret_cast<bf16x8*>(&w); } while (0)
    PK4(p0, 0, pa0); PK4(p0, 8, pa1); PK4(p1, 0, pa2); PK4(p1, 8, pa3);
#undef PK4
}
template <int MODE> __device__ __forceinline__ void qkt(f32x16& p0, f32x16& p1, const char* Ks, const float* ckl, const bf16x8* qr, int r32, int hi) {
    if (MODE == 1) {
#pragma unroll
        for (int i = 0; i < 4; ++i) { const f32x4 a = *(const f32x4*)(ckl + 8 * i + 4 * hi), b = *(const f32x4*)(ckl + 32 + 8 * i + 4 * hi);
            p0[4 * i] = a[0]; p0[4 * i + 1] = a[1]; p0[4 * i + 2] = a[2]; p0[4 * i + 3] = a[3];
            p1[4 * i] = b[0]; p1[4 * i + 1] = b[1]; p1[4 * i + 2] = b[2]; p1[4 * i + 3] = b[3]; }
    } else { p0 = f32x16{}; p1 = f32x16{}; }
#pragma unroll
    for (int d0 = 0; d0 < 8; ++d0) { const int cb = (d0 * 16 + hi * 8) * 2;
        bf16x8 b0 = *reinterpret_cast<const bf16x8*>(Ks + KSWZ(r32, cb));
        bf16x8 b1 = *reinterpret_cast<const bf16x8*>(Ks + KSWZ(32 + r32, cb));
        p0 = __builtin_amdgcn_mfma_f32_32x32x16_bf16(b0, qr[d0], p0, 0, 0, 0);
        p1 = __builtin_amdgcn_mfma_f32_32x32x16_bf16(b1, qr[d0], p1, 0, 0, 0); }
}
__device__ __forceinline__ int v_st(int k, int c) { const int kk = (k & ~0xC) | ((k & 4) << 1) | ((k & 8) >> 1); return ((kk >> 3) * 4 + (c >> 5)) * 512 + ((kk & 7) * 32 + (c & 31)) * 2; }
__device__ __forceinline__ int v_rd_base(int lane) { return ((lane & 3) << 3) | (((lane >> 2) & 3) << 6) | (((lane >> 4) & 1) << 5) | (((lane >> 5) & 1) << 8); }
constexpr int v_rd_off(int d0, int ks, int half) { return d0 * 512 + ks * 4096 + half * 2048; }
template <int OFF> __device__ __forceinline__ s16x4 tr_read(int vb) {
    s16x4 r; asm volatile("ds_read_b64_tr_b16 %0, %1 offset:%2" : "=&v"(r) : "v"(vb), "i"(OFF) : "memory"); return r;
}
template <int D0> __device__ __forceinline__ void pv_one(f32x16& od, int vb, bf16x8 pa0, bf16x8 pa1, bf16x8 pa2, bf16x8 pa3) {
    const s16x4 l0 = tr_read<v_rd_off(D0, 0, 0)>(vb), h0 = tr_read<v_rd_off(D0, 0, 1)>(vb), l1 = tr_read<v_rd_off(D0, 1, 0)>(vb), h1 = tr_read<v_rd_off(D0, 1, 1)>(vb);
    const s16x4 l2 = tr_read<v_rd_off(D0, 2, 0)>(vb), h2 = tr_read<v_rd_off(D0, 2, 1)>(vb), l3 = tr_read<v_rd_off(D0, 3, 0)>(vb), h3 = tr_read<v_rd_off(D0, 3, 1)>(vb);
    asm volatile("s_waitcnt lgkmcnt(0)" ::: "memory"); SBAR();
#define PK(L, H) (bf16x8){L[0], L[1], L[2], L[3], H[0], H[1], H[2], H[3]}
    od = __builtin_amdgcn_mfma_f32_32x32x16_bf16(pa0, PK(l0, h0), od, 0, 0, 0);
    od = __builtin_amdgcn_mfma_f32_32x32x16_bf16(pa1, PK(l1, h1), od, 0, 0, 0);
    od = __builtin_amdgcn_mfma_f32_32x32x16_bf16(pa2, PK(l2, h2), od, 0, 0, 0);
    od = __builtin_amdgcn_mfma_f32_32x32x16_bf16(pa3, PK(l3, h3), od, 0, 0, 0);
#undef PK
}
__device__ __forceinline__ void pv_d0(f32x16* o, int vb, bf16x8 pa0, bf16x8 pa1, bf16x8 pa2, bf16x8 pa3) {
    pv_one<0>(o[0], vb, pa0, pa1, pa2, pa3); pv_one<1>(o[1], vb, pa0, pa1, pa2, pa3); pv_one<2>(o[2], vb, pa0, pa1, pa2, pa3); pv_one<3>(o[3], vb, pa0, pa1, pa2, pa3);
}
template <int MODE, int LD, int SD>
__device__ __forceinline__ void attn_unit(const bf16_t* __restrict__ Qb, const bf16_t* __restrict__ Kh, const bf16_t* __restrict__ Vh, int qb,
                                          const float* __restrict__ nck, float* __restrict__ Of, bf16_t* __restrict__ Ob, const bf16_t* __restrict__ Gb, char* lds, int wv) {
    const int tid = tidw(wv), wid = wv, lane = tid & 63, r32 = lane & 31, hi = lane >> 5;
    char* V_lds = lds; char* K_lds = lds + OFF_K;
    float* ws = (float*)(lds + OFF_WS) + wid * 64; float* li_l = ws; float* al_l = ws + 32;
    float* ck_lds = (float*)(lds + OFF_CK);
    float m_reg = -1e30f, l_reg = 0; f32x16 o[4] = {}; bf16x8 qr[8];
    const bf16_t* Qw = Qb + (long)(wid * QBLK + r32) * LD + hi * 8;
#pragma unroll
    for (int d0 = 0; d0 < 8; ++d0) qr[d0] = *reinterpret_cast<const bf16x8*>(Qw + d0 * 16);
    const int sr = tid >> 4, sc = (tid & 15) * 8, vst0 = v_st(sr, sc), vst1 = v_st(32 + sr, sc);
    const int vb0 = (int)(uintptr_t)V_lds + v_rd_base(lane);
    struct { bf16x8 vs0, vs1, ks0, ks1; float ck; } sr_[SD];
#define SLOAD(i, k0) do { sr_[i].vs0 = *reinterpret_cast<const bf16x8*>(&Vh[(long)((k0) + sr) * LD + sc]); sr_[i].vs1 = *reinterpret_cast<const bf16x8*>(&Vh[(long)((k0) + 32 + sr) * LD + sc]); \
    sr_[i].ks0 = *reinterpret_cast<const bf16x8*>(&Kh[(long)((k0) + sr) * LD + sc]); sr_[i].ks1 = *reinterpret_cast<const bf16x8*>(&Kh[(long)((k0) + 32 + sr) * LD + sc]); \
    if (MODE == 1) { if (tid < 64) sr_[i].ck = nck[(k0) + tid]; } } while (0)
#define SWRITE(b, i) do { *(bf16x8*)(V_lds + (b) * SHM_V + vst0) = sr_[i].vs0;          \
    *(bf16x8*)(V_lds + (b) * SHM_V + vst1) = sr_[i].vs1; const int kc = sc * 2;               \
    *(bf16x8*)(K_lds + (b) * SHM_K + KSWZ(sr, kc)) = sr_[i].ks0;                       \
    *(bf16x8*)(K_lds + (b) * SHM_K + KSWZ(32 + sr, kc)) = sr_[i].ks1; \
    if (MODE == 1) { if (tid < 64) ck_lds[(b) * 64 + tid] = sr_[i].ck; } } while (0)
#define SWAIT() do { if (SD == 2) asm volatile("s_waitcnt vmcnt(4)" ::: "memory"); else asm volatile("s_waitcnt vmcnt(0)" ::: "memory"); } while (0)
#define RESC(a) do { if (__any((a) < 1.f)) { if (hi == 0) al_l[r32] = (a); asm volatile("s_waitcnt lgkmcnt(0)" ::: "memory"); \
    _Pragma("unroll") for (int d = 0; d < 4; ++d) _Pragma("unroll") for (int r = 0; r < 16; ++r) o[d][r] *= al_l[crow(r, hi)]; } } while (0)
    f32x16 pA0, pA1, pB0, pB1; float alA, alB; bf16x8 pa0, pa1, pa2, pa3; const int NT = 4 * qb + 4;
    const int qrel = wid * QBLK + r32;
    constexpr int SE = 0, SO = SD - 1;
    SLOAD(SE, 0); asm volatile("s_waitcnt vmcnt(0)" ::: "memory"); SWRITE(0, SE); __syncthreads();
    qkt<MODE>(pA0, pA1, K_lds, ck_lds, qr, r32, hi); maskp<MODE>(pA0, pA1, 0, NT, qb, wid, qrel, hi); partialSM(pA0, pA1, m_reg, alA);
    SLOAD(SO, KVBLK); if (SD == 2) { if (2 < NT) SLOAD(SE, 2 * KVBLK); }
    SWAIT(); SWRITE(1, SO); __syncthreads();
    for (int j = 1; j + 1 < NT; j += 2) {
        SBAR(); qkt<MODE>(pB0, pB1, K_lds + SHM_K, ck_lds + 64, qr, r32, hi); maskp<MODE>(pB0, pB1, j, NT, qb, wid, qrel, hi);
        finishSM(pA0, pA1, alA, l_reg, pa0, pa1, pa2, pa3); SBAR();
        SLOAD(SO, (j + SD) * KVBLK); SBAR();
        pv_d0(o, vb0, pa0, pa1, pa2, pa3); partialSM(pB0, pB1, m_reg, alB);
        __syncthreads(); SWAIT(); SWRITE(0, SE);
        RESC(alB); __syncthreads();
        SBAR(); qkt<MODE>(pA0, pA1, K_lds, ck_lds, qr, r32, hi); maskp<MODE>(pA0, pA1, j + 1, NT, qb, wid, qrel, hi);
        finishSM(pB0, pB1, alB, l_reg, pa0, pa1, pa2, pa3); SBAR();
        if (SD == 1 || j + 3 < NT) SLOAD(SE, (j + 1 + SD) * KVBLK); SBAR();
        pv_d0(o, vb0 + SHM_V, pa0, pa1, pa2, pa3); partialSM(pA0, pA1, m_reg, alA);
        __syncthreads(); SWAIT(); SWRITE(1, SO);
        RESC(alA); __syncthreads();
    }
    SBAR(); qkt<MODE>(pB0, pB1, K_lds + SHM_K, ck_lds + 64, qr, r32, hi); maskp<MODE>(pB0, pB1, NT - 1, NT, qb, wid, qrel, hi);
    finishSM(pA0, pA1, alA, l_reg, pa0, pa1, pa2, pa3); SBAR();
    pv_d0(o, vb0, pa0, pa1, pa2, pa3); partialSM(pB0, pB1, m_reg, alB);
    __syncthreads(); RESC(alB);
    finishSM(pB0, pB1, alB, l_reg, pa0, pa1, pa2, pa3); SBAR();
    pv_d0(o, vb0 + SHM_V, pa0, pa1, pa2, pa3);
    if (hi == 0) li_l[r32] = l_reg; asm volatile("s_waitcnt lgkmcnt(0)" ::: "memory");
    float rli[16];
#pragma unroll
    for (int r = 0; r < 16; ++r) rli[r] = __builtin_amdgcn_rcpf(li_l[crow(r, hi)]);
    if (MODE == 0) { float* Ow = Of + (long)(wid * QBLK) * 2048;
#pragma unroll
        for (int r = 0; r < 16; ++r) { const int orow = crow(r, hi);
#pragma unroll
            for (int d0 = 0; d0 < 4; ++d0) Ow[(long)orow * 2048 + d0 * 32 + r32] = o[d0][r] * rli[r]; } }
    else { bf16_t* Ow = Ob + (long)(wid * QBLK) * 2048; const bf16_t* Gw = Gb + (long)(wid * QBLK) * LD;
#pragma unroll
        for (int r = 0; r < 16; ++r) { const int orow = crow(r, hi);
#pragma unroll
            for (int d0 = 0; d0 < 4; ++d0) { const float g = bf2f(Gw[(long)orow * LD + d0 * 32 + r32]);
                Ow[(long)orow * 2048 + d0 * 32 + r32] = f2bf(o[d0][r] * rli[r] * sigmoid_f(g)); } } }
    __syncthreads();
#undef SLOAD
#undef SWRITE
#undef SWAIT
#undef RESC
}
#undef SBAR
}
#define LAS __attribute__((address_space(3)))
#define XB_TMO      128
#define XB_XCNT(j)  (256  + 64 * (j))
#define XB_XSUB(j)  (1280 + 64 * (j))
#define XB_XGEN(j)  (2304 + 64 * (j))
#define XB_TOP      3328
#define XB_TOPGEN   3392
#define XCD_BAR_WORDS 3456
#define XB_SPIN_CAP (1u << 18)

__device__ __forceinline__ unsigned xb_ld(unsigned* p)              { return __hip_atomic_load(p, __ATOMIC_RELAXED, __HIP_MEMORY_SCOPE_AGENT); }
__device__ __forceinline__ unsigned xb_add(unsigned* p, unsigned v) { return __hip_atomic_fetch_add(p, v, __ATOMIC_RELAXED, __HIP_MEMORY_SCOPE_AGENT); }
__device__ __forceinline__ unsigned xb_xcc_id() { return (unsigned)__builtin_amdgcn_s_getreg((3 << 11) | 20) & 0xFu; }
#define XB_SPIN(cond, bar) do { unsigned _sp = 0; while (cond) { __builtin_amdgcn_s_sleep(1); \
    if ((++_sp & 255u) == 0u) { if (xb_ld(&(bar)[XB_TMO])) break; if (_sp > XB_SPIN_CAP) { atomicAdd(&(bar)[XB_TMO], 1u); break; } } } } while (0)

struct XcdBarrier {
    unsigned* bar; unsigned x;
    volatile LAS unsigned* st;
};

__device__ __forceinline__ XcdBarrier xcd_barrier_post(unsigned* bar, volatile LAS unsigned* st) {
    XcdBarrier b; b.bar = bar; b.x = xb_xcc_id(); b.st = st;
    if (threadIdx.x == 0) (void)xb_add(&bar[XB_XCNT(b.x)], 1u);
    return b;
}
__device__ __forceinline__ void xcd_barrier_complete(unsigned* bar, unsigned x, unsigned& nloc, unsigned& nx) {
    const unsigned G = gridDim.x * gridDim.y * gridDim.z;
    unsigned sum, cnt, mine, sp = 0u;
    for (;;) {
        sum = 0u; cnt = 0u; mine = 0u;
#pragma unroll
        for (unsigned j = 0; j < 16; ++j) { const unsigned c = xb_ld(&bar[XB_XCNT(j)]); sum += c; cnt += (c > 0u) ? 1u : 0u; mine = (j == x) ? c : mine; }
        if (sum == G) break;
        __builtin_amdgcn_s_sleep(1);
        if ((++sp & 255u) == 0u) { if (xb_ld(&bar[XB_TMO])) break; if (sp > XB_SPIN_CAP) { atomicAdd(&bar[XB_TMO], 1u); break; } }
    }
    nloc = mine > 0u ? mine : 1u; nx = cnt > 0u ? cnt : 1u;
}

__device__ __forceinline__ void xcd_barrier(const XcdBarrier& b) {
    asm volatile("s_waitcnt vmcnt(0)" ::: "memory");
    __syncthreads();
    if (threadIdx.x == 0) {
        unsigned* bar = b.bar;
        __builtin_amdgcn_s_waitcnt(0);
        unsigned nloc = b.st[0], nx = b.st[1];
        if (nloc == 0u) { xcd_barrier_complete(bar, b.x, nloc, nx); b.st[0] = nloc; b.st[1] = nx; }
        const unsigned old = xb_add(&bar[XB_XSUB(b.x)], 1u);
        const unsigned gen = old / nloc;
        if (old + 1u == (gen + 1u) * nloc) {
            __builtin_amdgcn_fence(__ATOMIC_RELEASE, "agent");
            asm volatile("s_waitcnt vmcnt(0)" ::: "memory");
            const unsigned og = xb_add(&bar[XB_TOP], 1u);
            const unsigned tg = og / nx;
            if (og + 1u == (tg + 1u) * nx) xb_add(&bar[XB_TOPGEN], 1u);
            else XB_SPIN(xb_ld(&bar[XB_TOPGEN]) == tg, bar);
            __builtin_amdgcn_fence(__ATOMIC_ACQUIRE, "agent");
            xb_add(&bar[XB_XGEN(b.x)], 1u);
            asm volatile("s_waitcnt vmcnt(0)" ::: "memory");
        } else {
            XB_SPIN(xb_ld(&bar[XB_XGEN(b.x)]) == gen, bar);
            __builtin_amdgcn_fence(__ATOMIC_ACQUIRE, "agent");
            asm volatile("s_waitcnt vmcnt(0)" ::: "memory");
        }
    }
    __syncthreads();
}

__device__ __forceinline__ void fox_qknorm(bf16_t* P, const float* qn, const float* kn, int gw, int ngw, int lane) {
    const int dl = (lane & 15) * 8;
    const f32x4 q0 = *(const f32x4*)(qn + dl), q1 = *(const f32x4*)(qn + dl + 4), k0 = *(const f32x4*)(kn + dl), k1 = *(const f32x4*)(kn + dl + 4);
    for (int it0 = gw * 8; it0 < 2 * M; it0 += ngw * 8) {
        u32x4 xs[8][4];
#pragma unroll
        for (int q = 0; q < 8; ++q) { const int it = it0 + q; const bf16_t* row = P + (size_t)(it >> 1) * 8192 + (it & 1) * 2048;
#pragma unroll
            for (int j = 0; j < 4; ++j) xs[q][j] = *(const u32x4*)(row + j * 512 + lane * 8); }
#pragma unroll
        for (int q = 0; q < 8; ++q) { const int it = it0 + q, isk = it & 1; bf16_t* row = P + (size_t)(it >> 1) * 8192 + isk * 2048;
            const f32x4 w0 = isk ? k0 : q0, w1 = isk ? k1 : q1; const float mul = isk ? 1.f : QSCALE;
#pragma unroll
            for (int j = 0; j < 4; ++j) { const u32x4 x = xs[q][j];
                float f[8] = {bflo(x.x), bfhi(x.x), bflo(x.y), bfhi(x.y), bflo(x.z), bfhi(x.z), bflo(x.w), bfhi(x.w)};
                float s = 0.f;
#pragma unroll
                for (int i = 0; i < 8; ++i) s += f[i] * f[i];
                s += shx(s, 1); s += shx(s, 2); s += shx(s, 4); s += shx(s, 8);
                const float r = rsqrtf(s * (1.f / 128.f) + EPS) * mul;
                u32x4 o; o.x = cvtpk(f[0] * r * w0[0], f[1] * r * w0[1]); o.y = cvtpk(f[2] * r * w0[2], f[3] * r * w0[3]);
                o.z = cvtpk(f[4] * r * w1[0], f[5] * r * w1[1]); o.w = cvtpk(f[6] * r * w1[2], f[7] * r * w1[3]);
                *(u32x4*)(row + j * 512 + lane * 8) = o; } } }
}
__device__ __forceinline__ void fox_cumsum(const float* XF  , const float* bias, float* NCK, int hd, LAS float* scr, int tid) {
    const float b = bias[hd]; float v[16]; float run = 0.f;
    float fs[16];
#pragma unroll
    for (int i = 0; i < 16; ++i) fs[i] = 0.f;
#pragma unroll
    for (int ks = 0; ks < 8; ++ks) { const f32x4* p = (const f32x4*)(XF + (size_t)ks * M * 64 + (size_t)hd * M + tid * 16);
#pragma unroll
        for (int q = 0; q < 4; ++q) { const f32x4 t = p[q]; fs[4 * q] += t[0]; fs[4 * q + 1] += t[1]; fs[4 * q + 2] += t[2]; fs[4 * q + 3] += t[3]; } }
#pragma unroll
    for (int i = 0; i < 16; ++i) { run += logsigmoid_f(fs[i] + b); v[i] = run; }
    float inc = run; const int lane = tid & 63, wid = tid >> 6;
#pragma unroll
    for (int o = 1; o < 64; o <<= 1) { const float t = shup(inc, o); if (lane >= o) inc += t; }
    if (lane == 63) scr[wid] = inc;
    __syncthreads();
    float base = inc - run;
    for (int w = 0; w < wid; ++w) base += scr[w];
#pragma unroll
    for (int i = 0; i < 16; ++i) NCK[(size_t)hd * M + tid * 16 + i] = -(base + v[i]) * LOG2E;
    __syncthreads();
}
__device__ __forceinline__ void diff_combine(const float* O0, const float* O1, const float* q1, const float* k1, const float* q2, const float* k2, const float* sub, float lam_init,
                                             bf16_t* MIX, int gw, int ngw, int lane) {
    const float s1 = wave_sum(q1[lane] * k1[lane] + q1[lane + 64] * k1[lane + 64]), s2 = wave_sum(q2[lane] * k2[lane] + q2[lane + 64] * k2[lane + 64]);
    const float lam = __expf(s1) - __expf(s2) + lam_init; const float post = 1.f - lam_init;
    const f32x4 sw = *((const f32x4*)sub + lane);
    for (int it0 = gw * 8; it0 < M * 8; it0 += ngw * 8) {
        f32x4 a[8], b[8];
#pragma unroll
        for (int q = 0; q < 8; ++q) { const size_t off = (size_t)(it0 + q) * 256 + lane * 4; a[q] = *(const f32x4*)(O0 + off); b[q] = *(const f32x4*)(O1 + off); }
#pragma unroll
        for (int q = 0; q < 8; ++q) { const size_t off = (size_t)(it0 + q) * 256 + lane * 4; const f32x4 d = a[q] - lam * b[q];
            const float ss = wave_sum((d[0] * d[0] + d[1] * d[1]) + (d[2] * d[2] + d[3] * d[3]));
            const float r = rsqrtf(ss * (1.f / 256.f) + EPS) * post; const f32x4 o = d * r * sw;
            u32x2 p; p.x = cvtpk(o[0], o[1]); p.y = cvtpk(o[2], o[3]); *(u32x2*)(MIX + off) = p; } }
}
__device__ __forceinline__ void gdn_post(const bf16_t* OG, const bf16_t* Z, const float* onw, bf16_t* MIX, int gw, int ngw, int lane) {
    const int dl = (lane & 15) * 8; const f32x4 w0 = *(const f32x4*)(onw + dl), w1 = *(const f32x4*)(onw + dl + 4);
    const float w[8] = {w0[0], w0[1], w0[2], w0[3], w1[0], w1[1], w1[2], w1[3]};
    for (int it0 = gw * 8; it0 < M * 8; it0 += ngw * 8) {
        u32x4 xs[8], zs[8];
#pragma unroll
        for (int q = 0; q < 8; ++q) { const int it = it0 + q; const size_t off = (size_t)it * 512 + lane * 8;
            const int tok_ = it >> 3, hv_ = (it & 7) * 4 + (lane >> 4), j_ = lane & 15;
            xs[q] = *(const u32x4*)(OG + ((size_t)(((tok_ >> 6) * 32 + hv_) * 8 + (j_ >> 1)) * 64 + (tok_ & 63)) * 16 + 8 * (j_ & 1)); zs[q] = *(const u32x4*)(Z + off); }
#pragma unroll
        for (int q = 0; q < 8; ++q) { const size_t off = (size_t)(it0 + q) * 512 + lane * 8; const u32x4 x = xs[q], z = zs[q];
            const float f[8] = {bflo(x.x), bfhi(x.x), bflo(x.y), bfhi(x.y), bflo(x.z), bfhi(x.z), bflo(x.w), bfhi(x.w)};
            const float g[8] = {bflo(z.x), bfhi(z.x), bflo(z.y), bfhi(z.y), bflo(z.z), bfhi(z.z), bflo(z.w), bfhi(z.w)};
            float s = 0.f;
#pragma unroll
            for (int i = 0; i < 8; ++i) s += f[i] * f[i];
            s += shx(s, 1); s += shx(s, 2); s += shx(s, 4); s += shx(s, 8);
            const float r = rsqrtf(s * (1.f / 128.f) + EPS); float o[8];
#pragma unroll
            for (int i = 0; i < 8; ++i) o[i] = f[i] * r * w[i] * silu_m(g[i]);
            u32x4 p; p.x = cvtpk(o[0], o[1]); p.y = cvtpk(o[2], o[3]); p.z = cvtpk(o[4], o[5]); p.w = cvtpk(o[6], o[7]);
            *(u32x4*)(MIX + off) = p; } }
}

namespace gdn {
constexpr int QSTR = 136;
constexpr int OFF_QS = 0, OFF_KS = OFF_QS + 64 * QSTR * 2, OFF_VS = OFF_KS + 64 * QSTR * 2, OFF_KK = OFF_VS + 64 * 256 * 2, OFF_QK = OFF_KK + 16384, OFF_T1 = OFF_QK + 16384,
              OFF_SM = OFF_T1 + 16384, LDS_PREP = OFF_SM + 6 * 64 * 4;
struct TRow { f32x4 t[16]; };
template <int I> __device__ __forceinline__ void load_trow(TRow& R, const LAS float* T) {
#pragma unroll
    for (int jb = 0; jb < 16; ++jb) if (4 * jb < I) R.t[jb] = *(const LAS f32x4*)(T + I * 64 + 4 * jb);
}
struct TRow8 { f32x4 t[8]; };
template <int I> __device__ __forceinline__ void load_trow8(TRow8& R, const LAS float* T) {
#pragma unroll
    for (int jb = 0; jb < 8; ++jb) if (4 * jb < I) R.t[jb] = *(const LAS f32x4*)(T + I * 64 + 4 * jb);
}
template <int I> __device__ __forceinline__ void solve_rows(f32x2 (&xp)[32], const LAS float* T, const TRow8& cur) {
    if constexpr (I < 64) {
        TRow8 nxt;
        if constexpr (I + 1 < 64) load_trow8<I + 1>(nxt, T);
        asm volatile("" ::: "memory"); __builtin_amdgcn_sched_barrier(0);
        f32x2 r2 = {xp[I >> 1][I & 1], 0.f};
#pragma unroll
        for (int jb = 0; jb < 8; ++jb) if (4 * jb < I) {
            const f32x2 tlo = {cur.t[jb][0], cur.t[jb][1]}, thi = {cur.t[jb][2], cur.t[jb][3]};
            r2 -= tlo * xp[2 * jb];
            if (4 * jb + 2 < I) r2 -= thi * xp[2 * jb + 1]; }
#pragma unroll
        for (int jb = 8; jb < 16; ++jb) if (4 * jb < I) {
            const f32x4 tr = *(const LAS f32x4*)(T + I * 64 + 4 * jb);
            const f32x2 tlo = {tr[0], tr[1]}, thi = {tr[2], tr[3]};
            r2 -= tlo * xp[2 * jb];
            if (4 * jb + 2 < I) r2 -= thi * xp[2 * jb + 1]; }
        xp[I >> 1][I & 1] = r2[0] + r2[1];
        solve_rows<I + 1>(xp, T, nxt);
    }
}
__device__ __forceinline__ void prep_unit(int hk, int n, const bf16_t* __restrict__ RAW, const float* __restrict__ XF, const float* __restrict__ convw, const float* __restrict__ a_log, const float* __restrict__ dt_bias,
                                          bf16_t* __restrict__ QN, bf16_t* __restrict__ KT, bf16_t* __restrict__ UT, bf16_t* __restrict__ NWB, bf16_t* __restrict__ INTRA, float* __restrict__ GCG, LAS unsigned char* lds, int wv) {
    const int tid = tidw(wv), wid = wv, lane = tid & 63, t0 = n * 64;
    LAS bf16_t* QS = (LAS bf16_t*)(lds + OFF_QS); LAS bf16_t* KS = (LAS bf16_t*)(lds + OFF_KS); LAS bf16_t* VS = (LAS bf16_t*)(lds + OFF_VS);
    LAS float* KK = (LAS float*)(lds + OFF_KK); LAS float* QK = (LAS float*)(lds + OFF_QK); LAS float* T1 = (LAS float*)(lds + OFF_T1);
    LAS float* BETA = (LAS float*)(lds + OFF_SM); LAS float* GC = BETA + 128; LAS float* EGC = GC + 128;
    { const int part = lane >> 4, cg = lane & 15;
      const int ch = (part == 0 ? hk * 128 : part == 1 ? 2048 + hk * 128 : 4096 + (2 * hk + (part - 2)) * 128) + cg * 8;
      float cw[4][8];
#pragma unroll
      for (int j = 0; j < 4; ++j) { const f32x4 a = *(const f32x4*)(convw + (size_t)j * 8192 + ch), b = *(const f32x4*)(convw + (size_t)j * 8192 + ch + 4);
          cw[j][0] = a[0]; cw[j][1] = a[1]; cw[j][2] = a[2]; cw[j][3] = a[3]; cw[j][4] = b[0]; cw[j][5] = b[1]; cw[j][6] = b[2]; cw[j][7] = b[3]; }
      float x0[8], x1[8], x2[8], x3[8];
      const int tb = t0 + wid * 8;
#define LDROW(dst, t) do { if ((t) >= 0) { const u32x4 w_ = *(const u32x4*)(RAW + (size_t)(t) * 8192 + ch); dst[0] = bflo(w_.x); dst[1] = bfhi(w_.x); dst[2] = bflo(w_.y); dst[3] = bfhi(w_.y); \
          dst[4] = bflo(w_.z); dst[5] = bfhi(w_.z); dst[6] = bflo(w_.w); dst[7] = bfhi(w_.w); } else { _Pragma("unroll") for (int i_ = 0; i_ < 8; ++i_) dst[i_] = 0.f; } } while (0)
      LDROW(x0, tb - 3); LDROW(x1, tb - 2); LDROW(x2, tb - 1);
#pragma unroll
      for (int i = 0; i < 8; ++i) {
          LDROW(x3, tb + i);
          float y[8]; float ss = 0.f;
#pragma unroll
          for (int c = 0; c < 8; ++c) { const float a = cw[0][c] * x0[c] + cw[1][c] * x1[c] + cw[2][c] * x2[c] + cw[3][c] * x3[c]; y[c] = silu_m(a); ss += y[c] * y[c]; }
          ss += shx(ss, 1); ss += shx(ss, 2); ss += shx(ss, 4); ss += shx(ss, 8);
          float mul = 1.f; if (part < 2) mul = rsqrtf(ss + EPS) * (part == 0 ? 0.08838834764831845f : 1.f);
          u32x4 o; o.x = cvtpk(y[0] * mul, y[1] * mul); o.y = cvtpk(y[2] * mul, y[3] * mul); o.z = cvtpk(y[4] * mul, y[5] * mul); o.w = cvtpk(y[6] * mul, y[7] * mul);
          const int tt = wid * 8 + i;
          if (part == 0) *(LAS u32x4*)(QS + tt * QSTR + cg * 8) = o; else if (part == 1) *(LAS u32x4*)(KS + tt * QSTR + cg * 8) = o; else *(LAS u32x4*)(VS + tt * 256 + (part - 2) * 128 + cg * 8) = o;
#pragma unroll
          for (int c = 0; c < 8; ++c) { x0[c] = x1[c]; x1[c] = x2[c]; x2[c] = x3[c]; }
      }
#undef LDROW
    }
    if (tid < 128) { const int j = tid >> 6, i = tid & 63, hv = 2 * hk + j; const float* xr = XF + (size_t)(t0 + i) * 64;
        float xb = 0.f, xa = 0.f;
#pragma unroll
        for (int ks = 0; ks < 8; ++ks) { xb += xr[(size_t)ks * M * 64 + hv]; xa += xr[(size_t)ks * M * 64 + 32 + hv]; }
        const float be = sigmoid_f(xb); const float g = -__expf(a_log[hv]) * softplus_f(xa + dt_bias[hv]);
        float inc = g;
#pragma unroll
        for (int o = 1; o < 64; o <<= 1) { const float t = shup(inc, o); if (i >= o) inc += t; }
        BETA[j * 64 + i] = be; GC[j * 64 + i] = inc; EGC[j * 64 + i] = __expf(inc); GCG[(size_t)(n * 32 + hv) * 64 + i] = inc; }
    __syncthreads();
    { const int prod = wid >> 2, ti = wid & 3, g4 = lane >> 4, l15 = lane & 15; LAS bf16_t* As = prod ? QS : KS; LAS float* Out = prod ? QK : KK;
      bf16x8 af[4];
#pragma unroll
      for (int s = 0; s < 4; ++s) af[s] = *(LAS bf16x8*)(As + (16 * ti + l15) * QSTR + 32 * s + 8 * g4);
#pragma unroll
      for (int tj = 0; tj < 4; ++tj) { f32x4 acc = {0.f, 0.f, 0.f, 0.f};
#pragma unroll
          for (int s = 0; s < 4; ++s) { const bf16x8 bfg = *(LAS bf16x8*)(KS + (16 * tj + l15) * QSTR + 32 * s + 8 * g4); acc = __builtin_amdgcn_mfma_f32_16x16x32_bf16(af[s], bfg, acc, 0, 0, 0); }
#pragma unroll
          for (int r = 0; r < 4; ++r) Out[(16 * ti + 4 * g4 + r) * 64 + 16 * tj + l15] = acc[r]; } }
    __syncthreads();
    { const int i = tid >> 3, j0 = (tid & 7) * 8;
      const float gi0 = GC[i], gi1 = GC[64 + i], bi0 = BETA[i], bi1 = BETA[64 + i];
      float in0[8], in1[8];
#pragma unroll
      for (int jj = 0; jj < 8; ++jj) { const int j = j0 + jj; const float kk = KK[i * 64 + j], qk = QK[i * 64 + j];
          const float d0 = __expf(gi0 - GC[j]), d1 = __expf(gi1 - GC[64 + j]);
          T1[i * 64 + j] = (j < i) ? bi1 * kk * d1 : 0.f; KK[i * 64 + j] = (j < i) ? bi0 * kk * d0 : 0.f;
          in0[jj] = (j <= i) ? qk * d0 : 0.f; in1[jj] = (j <= i) ? qk * d1 : 0.f; }
      u32x4 p0, p1; p0.x = cvtpk(in0[0], in0[1]); p0.y = cvtpk(in0[2], in0[3]); p0.z = cvtpk(in0[4], in0[5]); p0.w = cvtpk(in0[6], in0[7]);
      p1.x = cvtpk(in1[0], in1[1]); p1.y = cvtpk(in1[2], in1[3]); p1.z = cvtpk(in1[4], in1[5]); p1.w = cvtpk(in1[6], in1[7]);
      { const int fo = (((i >> 4) * 2 + (j0 >> 5)) * 64 + (i & 15) + 16 * ((j0 & 31) >> 3)) * 8;
        *(u32x4*)(INTRA + (size_t)(n * 32 + 2 * hk) * 4096 + fo) = p0; *(u32x4*)(INTRA + (size_t)(n * 32 + 2 * hk + 1) * 4096 + fo) = p1; }
#pragma unroll
      for (int rep = 0; rep < 2; ++rep) { const int idx = tid + rep * 512, r = idx >> 4, c8 = (idx & 15) * 8; *(u32x4*)(QN + (size_t)(n * 16 + hk) * 8192 + (((r >> 4) * 4 + (c8 >> 5)) * 64 + (r & 15) + 16 * ((c8 & 31) >> 3)) * 8) = *(LAS u32x4*)(QS + r * QSTR + c8); }
      { const int d = tid & 127, cq = tid >> 7; unsigned wv[8];
#pragma unroll
        for (int c2 = 0; c2 < 8; ++c2) { const unsigned lo = KS[(16 * cq + 2 * c2) * QSTR + d], hi = KS[(16 * cq + 2 * c2 + 1) * QSTR + d]; wv[c2] = lo | (hi << 16); }
        bf16_t* dst = KT + (size_t)(n * 16 + hk) * 8192 + (((d >> 4) * 2 + (cq >> 1)) * 64 + (d & 15) + 32 * (cq & 1)) * 8;
        *(u32x4*)dst = (u32x4){wv[0], wv[1], wv[2], wv[3]}; *(u32x4*)(dst + 16 * 8) = (u32x4){wv[4], wv[5], wv[6], wv[7]}; } }
    __syncthreads();
    { const int j = tid >> 8, col = tid & 255, hv = 2 * hk + j; int toff = j ? OFF_T1 : OFF_KK; asm volatile("" : "+v"(toff)); const LAS float* T = (const LAS float*)(lds + toff);
      f32x2 xp[32];
      if (col < 128) {
#pragma unroll
          for (int i = 0; i < 64; ++i) xp[i >> 1][i & 1] = bf2f(VS[i * 256 + j * 128 + col]) * BETA[j * 64 + i];
      } else {
#pragma unroll
          for (int i = 0; i < 64; ++i) xp[i >> 1][i & 1] = bf2f(KS[i * QSTR + (col - 128)]) * BETA[j * 64 + i] * EGC[j * 64 + i];
      }
      { TRow8 r1; load_trow8<1>(r1, T); solve_rows<1>(xp, T, r1); }
      if (col < 128) { bf16_t* dst = UT + (size_t)(n * 32 + hv) * 8192 + (((col >> 4) * 4) * 64 + (col & 15)) * 4;
#pragma unroll
          for (int q4 = 0; q4 < 16; ++q4) { u32x2 p; p.x = cvtpk(xp[2 * q4][0], xp[2 * q4][1]); p.y = cvtpk(xp[2 * q4 + 1][0], xp[2 * q4 + 1][1]);
              *(u32x2*)(dst + ((q4 >> 2) * 64 + 16 * (q4 & 3)) * 4) = p; } }
      else { const int d = col - 128; bf16_t* dst = NWB + (size_t)(n * 32 + hv) * 8192 + ((d >> 5) * 64 + 16 * ((d & 31) >> 3)) * 8 + (d & 7);
#pragma unroll
          for (int i = 0; i < 64; ++i) { *dst = f2bf(-xp[i >> 1][i & 1]); dst += ((i & 15) == 15) ? (2048 - 15 * 8) : 8; asm volatile("" : "+v"(dst)); } } }
    __syncthreads();
}

constexpr int SSTR = 136, VSTR = 72;
constexpr int OFF_ST = 0, OFF_VN = OFF_ST + 16 * SSTR * 2, OFF_VSC = OFF_VN + 16 * VSTR * 2, LDS_SCAN = OFF_VSC + 16 * VSTR * 2;
__device__ __forceinline__ void scan_item(int hv, int cb, const bf16_t* __restrict__ QN, const bf16_t* __restrict__ KT, const bf16_t* __restrict__ UT, const bf16_t* __restrict__ NWB, const bf16_t* __restrict__ INTRA,
                                          const float* __restrict__ GCG, bf16_t* __restrict__ OG, LAS unsigned char* lds, int wv) {
    const int tid = tidw(wv), w = wv, lane = tid & 63, g4 = lane >> 4, l15 = lane & 15, wq = w & 3, hk = hv >> 1;
    LAS bf16_t* ST = (LAS bf16_t*)(lds + OFF_ST); LAS bf16_t* VN = (LAS bf16_t*)(lds + OFF_VN); LAS bf16_t* VSC = (LAS bf16_t*)(lds + OFF_VSC);
    for (int i = tid; i < 16 * SSTR / 2; i += NTHREADS) ((LAS unsigned*)ST)[i] = 0u;
    f32x4 Sacc = {0.f, 0.f, 0.f, 0.f};
    __syncthreads();
    struct Ops { bf16x8 a1[4]; bf16x8 ax[4]; u32x2 u; f32x4 gc; float gl; };
    const bf16_t* p1base = (w < 4) ? NWB + (size_t)hv * 8192 + (wq * 256 + lane) * 8 : QN + (size_t)hk * 8192 + (wq * 256 + lane) * 8;
    const size_t p1stride = (w < 4) ? (size_t)32 * 64 * 128 : (size_t)16 * 64 * 128;
    f32x4 Sacc1 = {0.f, 0.f, 0.f, 0.f};
    const bf16_t* pa1 = p1base;
    const bf16_t* pax = (w >= 4) ? INTRA + (size_t)hv * 4096 + (wq * 128 + lane) * 8 : KT + (size_t)hk * 8192 + (w * 128 + lane) * 8;
    const size_t axstride = (w >= 4) ? (size_t)32 * 64 * 64 : (size_t)16 * 128 * 64;
    const bf16_t* pu = UT + (size_t)hv * 8192 + ((cb * 4 + wq) * 64 + lane) * 4;
    const float* pgc = GCG + (size_t)hv * 64 + 16 * wq + 4 * g4;
    const float* pgl = GCG + (size_t)hv * 64 + 63;
    bf16_t* pog = OG + ((size_t)(hv * 8 + cb) * 64 + 16 * wq) * 16;
    LAS bf16_t* OT = (LAS bf16_t*)(lds + LDS_SCAN);
#define LOADOPS(O, n) do { \
      _Pragma("unroll") for (int s = 0; s < 4; ++s) O.a1[s] = *(const bf16x8*)(pa1 + 512 * s); \
      O.ax[0] = *(const bf16x8*)(pax); O.ax[1] = *(const bf16x8*)(pax + 512); \
      if (w < 4) { O.ax[2] = *(const bf16x8*)(pax + 4096); O.ax[3] = *(const bf16x8*)(pax + 4096 + 512); O.u = *(const u32x2*)(pu); } \
      O.gc = *(const f32x4*)(pgc); O.gl = *pgl; \
      pa1 += p1stride; pax += axstride; pu += 32 * 128 * 64; pgc += 32 * 64; pgl += 32 * 64; } while (0)
#define SCAN_STEP(O_, n) do { \
        f32x4 acc, acc2 = {0.f, 0.f, 0.f, 0.f}; \
        if (w < 4) acc = (f32x4){bflo(O_.u.x), bfhi(O_.u.x), bflo(O_.u.y), bfhi(O_.u.y)}; else acc = (f32x4){0.f, 0.f, 0.f, 0.f}; \
        { const bf16x8 b0 = *(LAS bf16x8*)(ST + l15 * SSTR + 8 * g4), b1 = *(LAS bf16x8*)(ST + l15 * SSTR + 32 + 8 * g4), b2 = *(LAS bf16x8*)(ST + l15 * SSTR + 64 + 8 * g4), b3 = *(LAS bf16x8*)(ST + l15 * SSTR + 96 + 8 * g4); \
          acc = __builtin_amdgcn_mfma_f32_16x16x32_bf16(O_.a1[0], b0, acc, 0, 0, 0); acc2 = __builtin_amdgcn_mfma_f32_16x16x32_bf16(O_.a1[2], b2, acc2, 0, 0, 0); \
          acc = __builtin_amdgcn_mfma_f32_16x16x32_bf16(O_.a1[1], b1, acc, 0, 0, 0); acc2 = __builtin_amdgcn_mfma_f32_16x16x32_bf16(O_.a1[3], b3, acc2, 0, 0, 0); acc = acc + acc2; } \
        if (w < 4) { u32x2 p; p.x = cvtpk(acc[0], acc[1]); p.y = cvtpk(acc[2], acc[3]); *(LAS u32x2*)(VN + l15 * VSTR + 16 * wq + 4 * g4) = p; \
            const float e0 = __expf(O_.gl - O_.gc[0]), e1 = __expf(O_.gl - O_.gc[1]), e2 = __expf(O_.gl - O_.gc[2]), e3 = __expf(O_.gl - O_.gc[3]); \
            p.x = cvtpk(acc[0] * e0, acc[1] * e1); p.y = cvtpk(acc[2] * e2, acc[3] * e3); *(LAS u32x2*)(VSC + l15 * VSTR + 16 * wq + 4 * g4) = p; } \
        else { acc[0] *= __expf(O_.gc[0]); acc[1] *= __expf(O_.gc[1]); acc[2] *= __expf(O_.gc[2]); acc[3] *= __expf(O_.gc[3]); } \
        __syncthreads(); \
        if (w >= 4) { \
            _Pragma("unroll") \
            for (int s = 0; s < 2; ++s) { const bf16x8 b = *(LAS bf16x8*)(VN + l15 * VSTR + 32 * s + 8 * g4); acc = __builtin_amdgcn_mfma_f32_16x16x32_bf16(O_.ax[s], b, acc, 0, 0, 0); } \
            { LAS bf16_t* ot = OT + (w - 4) * 256;        \
              _Pragma("unroll") \
              for (int r = 0; r < 4; ++r) ot[(4 * g4 + r) * 16 + l15] = f2bf(acc[r]); \
              asm volatile("s_waitcnt lgkmcnt(0)" ::: "memory"); \
              if (lane < 32) *(u32x4*)(pog + lane * 8) = *(LAS u32x4*)(ot + lane * 8); } } \
        else { const float eg = __expf(O_.gl); Sacc = Sacc * eg; Sacc1 = Sacc1 * eg; \
            const bf16x8 b0 = *(LAS bf16x8*)(VSC + l15 * VSTR + 8 * g4), b1 = *(LAS bf16x8*)(VSC + l15 * VSTR + 32 + 8 * g4); \
            Sacc = __builtin_amdgcn_mfma_f32_16x16x32_bf16(O_.ax[0], b0, Sacc, 0, 0, 0); Sacc1 = __builtin_amdgcn_mfma_f32_16x16x32_bf16(O_.ax[2], b0, Sacc1, 0, 0, 0); \
            Sacc = __builtin_amdgcn_mfma_f32_16x16x32_bf16(O_.ax[1], b1, Sacc, 0, 0, 0); Sacc1 = __builtin_amdgcn_mfma_f32_16x16x32_bf16(O_.ax[3], b1, Sacc1, 0, 0, 0); \
            u32x2 p; p.x = cvtpk(Sacc[0], Sacc[1]); p.y = cvtpk(Sacc[2], Sacc[3]); *(LAS u32x2*)(ST + l15 * SSTR + 16 * w + 4 * g4) = p; \
            p.x = cvtpk(Sacc1[0], Sacc1[1]); p.y = cvtpk(Sacc1[2], Sacc1[3]); *(LAS u32x2*)(ST + l15 * SSTR + 16 * (w + 4) + 4 * g4) = p; } \
        pog += 32 * 8 * 64 * 16; __syncthreads(); \
    } while (0)
    Ops ring[4];
    LOADOPS(ring[0], 0); LOADOPS(ring[1], 1); LOADOPS(ring[2], 2);
    for (int nb = 0; nb < 128; nb += 4) {
#pragma unroll
        for (int k = 0; k < 4; ++k) { const int n = nb + k; LOADOPS(ring[(k + 3) % 4], n + 3); SCAN_STEP(ring[k], n); }
    }
#undef SCAN_STEP
#undef LOADOPS
}
}

constexpr size_t MiB = 1u << 20;
constexpr size_t WS_WIN = 0, WS_WOUT = 50 * MiB, WS_WGU = 66 * MiB, WS_WD = 110 * MiB;
constexpr size_t WS_H = 132 * MiB, WS_XN = 196 * MiB, WS_PROJ = 228 * MiB, WS_Z = 356 * MiB, WS_MIX = 420 * MiB;
constexpr size_t WS_G1 = 484 * MiB, WS_G2 = 548 * MiB, WS_G3 = 612 * MiB, WS_G4 = 644 * MiB, WS_G5 = 676 * MiB, WS_SM = 708 * MiB, WS_XF = 716 * MiB, WS_END = 732 * MiB;
constexpr size_t WS_CTL = WS_SM + 4 * MiB;
constexpr size_t XSLAB = (size_t)M * 64;
constexpr int LDS_BYTES = 147456;

#ifndef EN_MIX
#define EN_MIX 7
#endif
#ifndef EN_FFN
#define EN_FFN 1
#endif
struct Args { const float* in[25]; float* out; unsigned char* ws; };

typedef __attribute__((address_space(4))) const unsigned char* kargp_t;
__device__ __forceinline__ const float* kin(int i) {
    kargp_t kp = (kargp_t)__builtin_amdgcn_kernarg_segment_ptr(); asm volatile("" : "+s"(kp));
    return (const float*)*(const __attribute__((address_space(1))) float* const __attribute__((address_space(4)))*)(kp + 8 * i);
}
__global__ void __launch_bounds__(NTHREADS) mega_fwd(Args args) {
    extern __shared__ __attribute__((aligned(16))) unsigned char lds[];
    cg::grid_group grid = cg::this_grid();
    LAS unsigned char* L = (LAS unsigned char*)lds;
#define G opq_i((int)gridDim.x)
#define bid opq_i((int)blockIdx.x)
    const int WV = __builtin_amdgcn_readfirstlane((int)threadIdx.x >> 6);
    { volatile LAS unsigned* st = (volatile LAS unsigned*)(L + LDS_BYTES - 16); if (threadIdx.x < 4) st[threadIdx.x] = 0u; __syncthreads();
      (void)xcd_barrier_post((unsigned*)(args.ws + WS_CTL), st); }
#define GSYNC() do { XcdBarrier b_; b_.bar = (unsigned*)WSP(WS_CTL); b_.x = xb_xcc_id(); b_.st = (volatile LAS unsigned*)(L + LDS_BYTES - 16); xcd_barrier(b_); } while (0)
    unsigned char* ws0 = args.ws;
#define PV const int tid = tidw(WV), lane = tid & 63, wave = WV; const int gw = bid * NWAVES + wave, ngw = G * NWAVES; LAS float* scr = (LAS float*)(L + wave * 16640); (void)lane; (void)gw; (void)ngw; (void)scr;
#define VCU ((G % 8 == 0) ? (bid % 8) * (G / 8) + bid / 8 : bid)
#define WSP(off) (ws0 + opq((size_t)(off)))
#define Win ((bf16_t*)WSP(WS_WIN))
#define Wout ((bf16_t*)WSP(WS_WOUT))
#define Wgu ((bf16_t*)WSP(WS_WGU))
#define Wd ((bf16_t*)WSP(WS_WD))
#define H ((float*)WSP(WS_H))
#define XN ((bf16_t*)WSP(WS_XN))
#define PROJ ((bf16_t*)WSP(WS_PROJ))
#define ZB ((bf16_t*)WSP(WS_Z))
#define MIX ((bf16_t*)WSP(WS_MIX))
#define OM0 ((float*)WSP(WS_G1))
#define OM1 ((float*)WSP(WS_G2))
#define UT ((bf16_t*)WSP(WS_G1))
#define NWB ((bf16_t*)WSP(WS_G2))
#define QN ((bf16_t*)WSP(WS_G3))
#define KT ((bf16_t*)WSP(WS_G4))
#define INTRA ((bf16_t*)WSP(WS_G5))
#define XF ((float*)WSP(WS_XF))
#define NCK ((float*)WSP(WS_SM + 2 * MiB))
#define GCG ((float*)WSP(WS_SM + 3 * MiB))

    if (args.out == nullptr) grid.sync();
#pragma unroll 1
    for (int layer = 0; layer < 4; ++layer) {
        const int kind = layer % 3, slot = layer / 3;
        { PV
            if (kind == 0) { cvt_matrix(kin(4) + (size_t)slot * 2048 * 6144, 6144, 0, 6144, 2048, Win, 0, 0, scr, gw, ngw, lane);
                             cvt_matrix(kin(5) + (size_t)slot * 2048 * 2048, 2048, 0, 2048, 2048, Wout, 0, 0, scr, gw, ngw, lane); }
            else if (kind == 1) { cvt_matrix(kin(11), 8208, 0, 8208, 2048, Win, 0, 0, scr, gw, ngw, lane);
                                  cvt_matrix(kin(12), 2048, 0, 2048, 2048, Wout, 0, 0, scr, gw, ngw, lane); }
            else { cvt_matrix(kin(16), 12352, 0, 12352, 2048, Win, 0, 0, scr, gw, ngw, lane);
                   cvt_matrix(kin(17), 2048, 0, 2048, 4096, Wout, 0, 0, scr, gw, ngw, lane); }
            cvt_matrix(kin(22) + (size_t)layer * 2048 * FF, FF, 0, FF, 2048, Wgu, 1, 0, scr, gw, ngw, lane);
            cvt_matrix(kin(23) + (size_t)layer * 2048 * FF, FF, 0, FF, 2048, Wgu, 2, 0, scr, gw, ngw, lane);
            cvt_matrix(kin(24) + (size_t)layer * FF * 2048, 2048, 0, 2048, FF, Wd, 0, 0, scr, gw, ngw, lane);
            if (layer == 0) norm_rows<false>(kin(0), kin(1), XN, nullptr, gw, ngw, lane);
            else norm_rows<false>(H, kin(1) + layer * DM, XN, nullptr, gw, ngw, lane);
        }
        GSYNC();
        if ((EN_MIX >> kind) & 1) {
        {
            const int N = kind == 0 ? 6144 : kind == 1 ? 8192 : 12288;
            pg8::Gemm g{XN, Win, M, N, DM, DM / 64}; pg8::StaticOrder S; S.init(M, N, G, bid);
            pg8::EpiStore E;
            if (kind == 0) E = pg8::EpiStore{PROJ, 6144, PROJ, 6144, 1 << 30, XF, 16, 1 << 30, 2048, QSCALE};
            else if (kind == 1) E = pg8::EpiStore{PROJ, 8192, PROJ, 8192, 1 << 30, XF, 16, 8192, 0, 1.f};
            else E = pg8::EpiStore{PROJ, 8192, ZB, 4096, 8192, XF, 64, 12288, 0, 1.f};
            pg8::gemm_phase<pg8::EpiStore, pg8::StaticOrder, true, true>(L, g, S, E, WV);
            if (kind != 0) {
                pg8::Gemm g2{XN, Win, M, N + 256, DM, 4}; pg8::SplitKOrder S2; S2.init(M, 8, N / 256, G, bid);
                pg8::EpiXF E2{XF, kind == 1 ? 16 : 64, XSLAB, kind == 1 ? 1 : 0};
                pg8::gemm_phase<pg8::EpiXF, pg8::SplitKOrder, true, true>(L, g2, S2, E2, WV);
            }
        }
        GSYNC();
        if (kind == 0) { {
            for (int idx = VCU; idx < 1024; idx += G) { const int v = idx & 255, i = idx >> 8, vh = v >> 3, s = v & 7; const int qb = i == 0 ? s : i == 1 ? 15 - s : i == 2 ? 16 + s : 31 - s;
                const int mp = vh >> 4, hd = (vh >> 1) & 7, vhalf = vh & 1;
                const bf16_t* Qb = PROJ + (size_t)(256 * qb) * 6144 + mp * 1024 + hd * 128; const bf16_t* Kh = PROJ + 2048 + mp * 1024 + hd * 128; const bf16_t* Vh = PROJ + 4096 + hd * 256 + vhalf * 128;
                float* Of = (mp ? OM1 : OM0) + (size_t)(256 * qb) * 2048 + hd * 256 + vhalf * 128;
                att::attn_unit<0, 6144, 2>(Qb, Kh, Vh, qb, nullptr, Of, nullptr, nullptr, (char*)lds, WV); } }
            GSYNC();
            PV
            diff_combine(OM0, OM1, kin(6) + slot * 128, kin(7) + slot * 128, kin(8) + slot * 128, kin(9) + slot * 128, kin(10) + slot * 256,
                         0.8f - 0.6f * expf(-0.3f * (float)layer), MIX, gw, ngw, lane);
        } else if (kind == 1) { { PV
            fox_qknorm(PROJ, kin(14), kin(15), gw, ngw, lane);
            for (int hd = bid; hd < 16; hd += G) fox_cumsum(XF, kin(13), NCK, hd, (LAS float*)L, tid); }
            GSYNC();
            for (int idx = VCU; idx < 512; idx += G) { const int v = idx & 255, i = idx >> 8, hd = v >> 4, s = v & 15; const int qb = i == 0 ? s : 31 - s;
                const bf16_t* Qb = PROJ + (size_t)(256 * qb) * 8192 + hd * 128; const bf16_t* Kh = PROJ + 2048 + hd * 128; const bf16_t* Vh = PROJ + 4096 + hd * 128;
                att::attn_unit<1, 8192, 1>(Qb, Kh, Vh, qb, NCK + (size_t)hd * M, nullptr, MIX + (size_t)(256 * qb) * 2048 + hd * 128, PROJ + (size_t)(256 * qb) * 8192 + 6144 + hd * 128, (char*)lds, WV); }
        } else {
            for (int u = bid; u < 2048; u += G) gdn::prep_unit(u & 15, u >> 4, PROJ, XF, kin(18), kin(19), kin(20), QN, KT, UT, NWB, INTRA, GCG, L, WV);
            GSYNC();
            for (int wi = bid; wi < 256; wi += G) gdn::scan_item(wi & 31, wi >> 5, QN, KT, UT, NWB, INTRA, GCG, PROJ  , L, WV);
            GSYNC();
            PV
            gdn_post(PROJ, ZB, kin(21), MIX, gw, ngw, lane);
        }
        GSYNC();
        {
            const int K = kind == 2 ? 4096 : 2048;
            pg8::Gemm g{MIX, Wout, M, DM, K, K / 64}; pg8::StaticOrder S; S.init(M, DM, G, bid);
            pg8::EpiRes E{layer == 0 ? kin(0) : (const float*)H, H, DM};
            pg8::gemm_phase<pg8::EpiRes, pg8::StaticOrder, true, true>(L, g, S, E, WV);
        }
        GSYNC();
        }
        if (EN_FFN) {
        { PV norm_rows<false>(H, kin(2) + layer * DM, XN, nullptr, gw, ngw, lane); }
        GSYNC();
        {
            pg8::Gemm g{XN, Wgu, M, 2 * FF, DM, DM / 64}; pg8::StaticOrder S; S.init(M, 2 * FF, G, bid);
            pg8::EpiSwiglu E{PROJ, FF};
            pg8::gemm_phase<pg8::EpiSwiglu, pg8::StaticOrder, true, true>(L, g, S, E, WV);
        }
        GSYNC();
        {
            pg8::Gemm g{PROJ, Wd, M, DM, FF, FF / 64}; pg8::StaticOrder S; S.init(M, DM, G, bid);
            pg8::EpiRes E{H, H, DM};
            pg8::gemm_phase<pg8::EpiRes, pg8::StaticOrder, true, true>(L, g, S, E, WV);
        }
        GSYNC();
        }
    }
    { PV norm_rows<true>(H, kin(3), nullptr, args.out, gw, ngw, lane); }
}

extern "C" void kernel_launch(void* const* d_in, const int* in_sizes, int n_in, void* d_out, int out_size, void* d_ws, size_t ws_size, hipStream_t stream) {
    static int grid_blocks = 0;
    if (grid_blocks == 0) {
        if (n_in != 25 || out_size != M * DM || ws_size < WS_END) { fprintf(stderr, "kernel_launch: unexpected shapes (n_in %d, out %d, ws %zu)\n", n_in, out_size, ws_size); grid_blocks = -1; return; }
        int dev = 0, cus = 0, per_cu = 0;
        hipGetDevice(&dev); hipDeviceGetAttribute(&cus, hipDeviceAttributeMultiprocessorCount, dev);
        hipFuncSetAttribute((const void*)mega_fwd, hipFuncAttributeMaxDynamicSharedMemorySize, LDS_BYTES);
        hipOccupancyMaxActiveBlocksPerMultiprocessor(&per_cu, (const void*)mega_fwd, NTHREADS, LDS_BYTES);
        if (per_cu < 1) per_cu = 1;
        grid_blocks = cus * 1;
        (void)hipGetLastError();
    }
    if (grid_blocks < 0) return;
    if (hipMemsetAsync((char*)d_ws + WS_CTL, 0, 16384, stream) != hipSuccess) { fprintf(stderr, "kernel_launch: memset failed\n"); return; }
    Args a{};
    for (int i = 0; i < 25; ++i) a.in[i] = (const float*)d_in[i];
    a.out = (float*)d_out; a.ws = (unsigned char*)d_ws;
    void* kargs[] = {&a};
    hipError_t e = hipLaunchCooperativeKernel((const void*)mega_fwd, dim3(grid_blocks), dim3(NTHREADS), kargs, LDS_BYTES, stream);
    if (e != hipSuccess) fprintf(stderr, "cooperative launch failed: %s (grid %d)\n", hipGetErrorString(e), grid_blocks);
}
```

```cpp
#include <hip/hip_runtime.h>
#include <hip/hip_cooperative_groups.h>
#include <cstdio>
#include <cstdint>
#include <cmath>
namespace cg = cooperative_groups;
__device__ __forceinline__ int lane_asm() { int l; asm volatile("v_mbcnt_lo_u32_b32 %0, -1, 0\n\tv_mbcnt_hi_u32_b32 %0, -1, %0" : "=v"(l)); return l; }
__device__ __forceinline__ int tidw(int wv) { return wv * 64 + lane_asm(); }
__device__ __forceinline__ size_t opq(size_t v) { asm volatile("" : "+s"(v)); return v; }
__device__ __forceinline__ float shx(float v, int o) { return __builtin_bit_cast(float, __builtin_amdgcn_ds_bpermute((lane_asm() ^ o) << 2, __builtin_bit_cast(int, v))); }
__device__ __forceinline__ float shup(float v, int o) { const int l = lane_asm(); return __builtin_bit_cast(float, __builtin_amdgcn_ds_bpermute((l >= o ? l - o : l) << 2, __builtin_bit_cast(int, v))); }
__device__ __forceinline__ int opq_i(int v) { asm volatile("" : "+s"(v)); return v; }
namespace pg8 {
#define PG8_LAS __attribute__((address_space(3)))
typedef unsigned short bf16_t;
typedef short bf16x8 __attribute__((ext_vector_type(8)));
typedef float f32x4 __attribute__((ext_vector_type(4)));
typedef unsigned u32x4 __attribute__((ext_vector_type(4)));
constexpr int BM = 256, BK = 64, HALF = 128, HTB = HALF * BK * 2  , STAGE_BYTES = 8 * HTB, NXCD = 8, WGM = 8;

__host__ __device__ __forceinline__ int lds_byte(int r, int c) { const int st = (r >> 4) * 2 + (c >> 5), rr = r & 15, cc = c & 31, ob = rr * 64 + cc * 2; return st * 1024 + (ob ^ (((ob >> 9) & 1) << 5)); }
__host__ __device__ __forceinline__ void stage_rc(int b, int& R, int& C) { const int st = b / 1024, sb = b % 1024, swz = sb ^ (((sb >> 9) & 1) << 5); R = (st >> 1) * 16 + swz / 64; C = (st & 1) * 32 + (swz % 64) / 2; }
__host__ __device__ __forceinline__ int perm32(int rho) { const int n = rho >> 4, i = rho & 15; return 8 * (i >> 2) + 4 * n + (i & 3); }

struct Unit { int pm, pn, ks; };
struct Gemm { const bf16_t* A; const bf16_t* Bt; int M, N, K; int kt; };

struct StaticOrder {
    int nM, nN, nwg, G, c;
    __host__ __device__ void init(int M, int N, int G_, int c_) { nM = M / BM; nN = N / BM; nwg = nM * nN; G = G_; c = c_; }
    __host__ __device__ bool next(int i, Unit& u) const {
        const long L = (long)i * G + c; if (L >= nwg) return false;
        int wgid = (int)L; { const int q = nwg / NXCD, r = nwg % NXCD, xcd = wgid % NXCD, off = wgid / NXCD; wgid = (xcd < r ? xcd * (q + 1) : r * (q + 1) + (xcd - r) * q) + off; }
        const int nig = WGM * nN, gid = wgid / nig, fm = gid * WGM, gsz = (nM - fm) < WGM ? (nM - fm) : WGM;
        u.pm = fm + ((wgid % nig) % gsz); u.pn = (wgid % nig) / gsz; u.ks = 0; return true;
    }
    __device__ __forceinline__ void a_ready(const Unit&) const {}
    __device__ __forceinline__ void done(const Unit&) const {}
};
struct SplitKOrder {
    int nunits, G, c, SK, pn;
    __host__ __device__ void init(int M, int SK_, int pn_, int G_, int c_) { nunits = (M / BM) * SK_; G = G_; c = c_; SK = SK_; pn = pn_; }
    __host__ __device__ bool next(int i, Unit& u) const { const int L = i * G + c; if (L >= nunits) return false; u.pm = L / SK; u.ks = L % SK; u.pn = pn; return true; }
    __device__ __forceinline__ void a_ready(const Unit&) const {}
    __device__ __forceinline__ void done(const Unit&) const {}
};


__device__ __forceinline__ unsigned cvt_pk_bf16(float lo, float hi) { unsigned r; asm volatile("v_cvt_pk_bf16_f32 %0, %1, %2" : "=v"(r) : "v"(lo), "v"(hi)); return r; }
typedef unsigned u32x2v __attribute__((ext_vector_type(2)));
typedef __bf16 bf16x2v_t __attribute__((ext_vector_type(2))); typedef float f32x2v_t __attribute__((ext_vector_type(2)));
__device__ __forceinline__ unsigned cvtpk2(float lo, float hi) { f32x2v_t v = {lo, hi}; bf16x2v_t b = __builtin_convertvector(v, bf16x2v_t); return __builtin_bit_cast(unsigned, b); }
struct EpiStore {
    static constexpr bool PERM = true, AFTER_DRAIN = false;
    bf16_t* O0; int ld0; bf16_t* O1; int ld1; int split;
    float* XF; int ldx; int xsplit;
    int qcols; float qscale;
    __device__ __forceinline__ void operator()(const f32x4 (&acc)[2][2][4][2], const Unit& u, int wr, int wc, int fr, int fq) const {
        const int row0 = u.pm * BM + wr * 64 + fr; int colt = u.pn * BM;
        if (colt >= xsplit) {
#pragma unroll
            for (int ai = 0; ai < 2; ++ai)
#pragma unroll
                for (int m = 0; m < 4; ++m) { const size_t row = (size_t)(row0 + ai * HALF + m * 16);
#pragma unroll
                    for (int n = 0; n < 2; ++n) { const int c = wc * 32 + 8 * fq + 4 * n; if (c < ldx) *(f32x4*)(XF + row * ldx + c) = acc[ai][0][m][n]; } }
            return;
        }
        const float sc = (colt < qcols) ? qscale : 1.f;
        bf16_t* base = O0; int ld = ld0; if (colt >= split) { base = O1; ld = ld1; colt -= split; }
        const int col0 = colt + wc * 32 + 8 * fq;
#pragma unroll
        for (int ai = 0; ai < 2; ++ai)
#pragma unroll
            for (int m = 0; m < 4; ++m) { bf16_t* rowp = base + (size_t)(row0 + ai * HALF + m * 16) * ld + col0;
#pragma unroll
                for (int bj = 0; bj < 2; ++bj) { const f32x4 v0 = acc[ai][bj][m][0] * sc, v1 = acc[ai][bj][m][1] * sc;
                    u32x4 w; w.x = cvt_pk_bf16(v0[0], v0[1]); w.y = cvt_pk_bf16(v0[2], v0[3]); w.z = cvt_pk_bf16(v1[0], v1[1]); w.w = cvt_pk_bf16(v1[2], v1[3]);
                    *(u32x4*)(rowp + bj * HALF) = w; } }
    }
};
__device__ __forceinline__ float silu_f(float x) { return x * __builtin_amdgcn_rcpf(1.f + __expf(-x)); }
struct EpiSwiglu {
    static constexpr bool PERM = true, AFTER_DRAIN = false;
    bf16_t* O; int ld;
    __device__ __forceinline__ void operator()(const f32x4 (&acc)[2][2][4][2], const Unit& u, int wr, int wc, int fr, int fq) const {
        const int row0 = u.pm * BM + wr * 64 + fr; const int col0 = u.pn * HALF + wc * 32 + 8 * fq;
#pragma unroll
        for (int ai = 0; ai < 2; ++ai)
#pragma unroll
            for (int m = 0; m < 4; ++m) { bf16_t* rowp = O + (size_t)(row0 + ai * HALF + m * 16) * ld + col0;
                const f32x4 g0 = acc[ai][0][m][0], g1 = acc[ai][0][m][1], u0 = acc[ai][1][m][0], u1 = acc[ai][1][m][1];
                u32x4 w; w.x = cvt_pk_bf16(silu_f(g0[0]) * u0[0], silu_f(g0[1]) * u0[1]); w.y = cvt_pk_bf16(silu_f(g0[2]) * u0[2], silu_f(g0[3]) * u0[3]);
                w.z = cvt_pk_bf16(silu_f(g1[0]) * u1[0], silu_f(g1[1]) * u1[1]); w.w = cvt_pk_bf16(silu_f(g1[2]) * u1[2], silu_f(g1[3]) * u1[3]);
                *(u32x4*)rowp = w; }
    }
};
struct EpiRes {
    static constexpr bool PERM = true, AFTER_DRAIN = false;
    const float* basef; const bf16_t* baseb; bf16_t* out; int ld;
    __device__ __forceinline__ void operator()(const f32x4 (&acc)[2][2][4][2], const Unit& u, int wr, int wc, int fr, int fq) const {
        const int row0 = u.pm * BM + wr * 64 + fr; const int col0 = u.pn * BM + wc * 32 + 8 * fq;
#pragma unroll
        for (int ai = 0; ai < 2; ++ai)
#pragma unroll
            for (int m = 0; m < 4; ++m) { const size_t off = (size_t)(row0 + ai * HALF + m * 16) * ld + col0;
#pragma unroll
                for (int bj = 0; bj < 2; ++bj) { f32x4 b0, b1;
                    if (basef) { b0 = *(const f32x4*)(basef + off + bj * HALF); b1 = *(const f32x4*)(basef + off + bj * HALF + 4); }
                    else { const u32x4 w = *(const u32x4*)(baseb + off + bj * HALF);
                        b0 = (f32x4){__uint_as_float(w.x << 16), __uint_as_float(w.x & 0xffff0000u), __uint_as_float(w.y << 16), __uint_as_float(w.y & 0xffff0000u)};
                        b1 = (f32x4){__uint_as_float(w.z << 16), __uint_as_float(w.z & 0xffff0000u), __uint_as_float(w.w << 16), __uint_as_float(w.w & 0xffff0000u)}; }
                    const f32x4 o0 = b0 + acc[ai][bj][m][0], o1 = b1 + acc[ai][bj][m][1];
                    u32x4 p; p.x = cvtpk2(o0[0], o0[1]); p.y = cvtpk2(o0[2], o0[3]); p.z = cvtpk2(o1[0], o1[1]); p.w = cvtpk2(o1[2], o1[3]);
                    *(u32x4*)(out + off + bj * HALF) = p; }
                if (m & 1) asm volatile("" ::: "memory"); }
    }
};

struct EpiXF {
    static constexpr bool PERM = true, AFTER_DRAIN = false;
    float* XF; int ldx; size_t slab; int tr;
    __device__ __forceinline__ void operator()(const f32x4 (&acc)[2][2][4][2], const Unit& u, int wr, int wc, int fr, int fq) const {
        const int row0 = u.pm * BM + wr * 64 + fr; float* base = XF + (size_t)u.ks * slab;
#pragma unroll
        for (int ai = 0; ai < 2; ++ai)
#pragma unroll
            for (int m = 0; m < 4; ++m) { const size_t row = (size_t)(row0 + ai * HALF + m * 16);
#pragma unroll
                for (int n = 0; n < 2; ++n) { const int c = wc * 32 + 8 * fq + 4 * n;
                    if (c < ldx) { if (tr) {
#pragma unroll
                            for (int q = 0; q < 4; ++q) base[(size_t)(c + q) * 8192 + row] = acc[ai][0][m][n][q]; }
                        else *(f32x4*)(base + row * ldx + c) = acc[ai][0][m][n]; } } }
    }
};
template <class Epi, class Sched, bool ALIGN_EPI = false, bool SP2 = false>
__device__ __forceinline__ void gemm_phase(PG8_LAS unsigned char* lds, const Gemm g, const Sched& S, const Epi& E, int wv) {
    const int tid = tidw(wv), wid = wv, lane = tid & 63, wr = wid >> 2, wc = wid & 3, fr = lane & 15, fq = lane >> 4;
    const int K = g.K, nt = g.kt; const size_t ksl = (size_t)g.kt * BK * 2;
    unsigned voffA[2], voffB[2];
#pragma unroll
    for (int i = 0; i < 2; ++i) { int R, C; stage_rc(tid * 16 + i * 8192, R, C); const int Rb = Epi::PERM ? ((R & ~31) + perm32(R & 31)) : R;
        voffA[i] = (unsigned)(R * K + C) * 2u; voffB[i] = (unsigned)(Rb * K + C) * 2u; }
    const size_t kstep = (size_t)(BK * 2);
    const size_t hstep = (size_t)HALF * K * 2;
    const size_t tstep = 2 * hstep;
    const unsigned ldsw = (unsigned)wid * 1024u;
    const int aoff = lds_byte(wr * 64 + fr, fq * 8), boff = lds_byte(wc * 32 + fr, fq * 8);
#define PG8_SA(b, h) (((b) * 2 + (h)) * HTB)
#define PG8_SB(b, h) ((4 + (b) * 2 + (h)) * HTB)
#define PG8_STAGE(bufoff, gbase, voff) do { _Pragma("unroll") for (int _i = 0; _i < 2; ++_i) \
        __builtin_amdgcn_global_load_lds((const unsigned*)((const char*)(gbase) + (voff)[_i]), (PG8_LAS unsigned*)(lds + (bufoff) + ldsw + _i * 8192), 16, 0, 0); } while (0)
#define PG8_LDA(dst, b, h) do { _Pragma("unroll") for (int m = 0; m < 4; ++m) _Pragma("unroll") for (int k = 0; k < 2; ++k) dst[m][k] = *(const PG8_LAS bf16x8*)(lds + PG8_SA(b, h) + aoff + m * 2048 + k * 1024); } while (0)
#define PG8_LDB(dst, b, h) do { _Pragma("unroll") for (int n = 0; n < 2; ++n) _Pragma("unroll") for (int k = 0; k < 2; ++k) dst[n][k] = *(const PG8_LAS bf16x8*)(lds + PG8_SB(b, h) + boff + n * 2048 + k * 1024); } while (0)
#define PG8_MMA(ai, bj, At, Bt) do { __builtin_amdgcn_s_setprio(1); _Pragma("unroll") for (int m = 0; m < 4; ++m) _Pragma("unroll") for (int n = 0; n < 2; ++n) _Pragma("unroll") for (int k = 0; k < 2; ++k) \
        acc[ai][bj][m][n] = __builtin_amdgcn_mfma_f32_16x16x32_bf16(Bt[n][k], At[m][k], acc[ai][bj][m][n], 0, 0, 0); __builtin_amdgcn_s_setprio(0); } while (0)
#define PG8_WAIT_V(n) asm volatile("s_waitcnt vmcnt(" #n ")" ::: "memory")
#define PG8_WAIT_L(n) asm volatile("s_waitcnt lgkmcnt(" #n ")" ::: "memory")
#define PG8_BAR __builtin_amdgcn_s_barrier()
#define PG8_SCHED __builtin_amdgcn_sched_barrier(0)
    Unit cur, nxt; int ui = 0;
    if (!S.next(0, cur)) return;
    f32x4 acc[2][2][4][2];
#pragma unroll
    for (int a = 0; a < 2; ++a)
#pragma unroll
        for (int b = 0; b < 2; ++b)
#pragma unroll
            for (int m = 0; m < 4; ++m)
#pragma unroll
                for (int n = 0; n < 2; ++n) acc[a][b][m][n] = (f32x4){0.f, 0.f, 0.f, 0.f};
    bf16x8 At[4][2], B0[2][2], B1[2][2];
    const char* cA = (const char*)g.A + (size_t)cur.pm * tstep + (size_t)cur.ks * ksl; const char* cB = (const char*)g.Bt + (size_t)cur.pn * tstep + (size_t)cur.ks * ksl;
    S.a_ready(cur);
    if constexpr (SP2) {
        PG8_STAGE(PG8_SB(0, 0), cB, voffB); PG8_STAGE(PG8_SB(0, 1), cB + hstep, voffB); PG8_STAGE(PG8_SA(0, 0), cA, voffA); PG8_STAGE(PG8_SA(0, 1), cA + hstep, voffA);
        if (wr == 1) PG8_BAR;
        PG8_WAIT_V(2); PG8_BAR;
        PG8_STAGE(PG8_SB(1, 0), cB + kstep, voffB); PG8_STAGE(PG8_SA(1, 0), cA + kstep, voffA); PG8_STAGE(PG8_SB(1, 1), cB + hstep + kstep, voffB);
        PG8_WAIT_V(6); PG8_BAR;
    } else {
        PG8_STAGE(PG8_SB(0, 0), cB, voffB); PG8_STAGE(PG8_SA(0, 0), cA, voffA); PG8_STAGE(PG8_SB(0, 1), cB + hstep, voffB); PG8_STAGE(PG8_SA(0, 1), cA + hstep, voffA);
        if (wr == 1) PG8_BAR;
        PG8_WAIT_V(4); PG8_BAR;
        PG8_STAGE(PG8_SB(1, 0), cB + kstep, voffB); PG8_STAGE(PG8_SA(1, 0), cA + kstep, voffA); PG8_STAGE(PG8_SB(1, 1), cB + hstep + kstep, voffB);
        PG8_WAIT_V(6); PG8_BAR;
    }
    for (;;) {
        const bool has_next = S.next(ui + 1, nxt);
        const char* nA = has_next ? (const char*)g.A + (size_t)nxt.pm * tstep + (size_t)nxt.ks * ksl : cA; const char* nB = has_next ? (const char*)g.Bt + (size_t)nxt.pn * tstep + (size_t)nxt.ks * ksl : cB;
        for (int t = 0; t < nt; t += 2) {
            const bool last = (t == nt - 2);
            const char* a1 = cA + (size_t)(t + 1) * kstep;
            const char* a2 = last ? nA : cA + (size_t)(t + 2) * kstep; const char* b2 = last ? nB : cB + (size_t)(t + 2) * kstep;
            const char* a3 = a2 + kstep; const char* b3 = b2 + kstep;
            if (last && has_next) S.a_ready(nxt);
            if constexpr (SP2) {
            PG8_LDB(B0, 0, 0); PG8_LDB(B1, 0, 1); PG8_SCHED; PG8_LDA(At, 0, 0); PG8_STAGE(PG8_SA(1, 1), a1 + hstep, voffA);
            PG8_WAIT_V(8); PG8_WAIT_L(0); PG8_BAR; PG8_MMA(0, 0, At, B0); PG8_MMA(0, 1, At, B1); PG8_BAR; PG8_SCHED;
            PG8_LDA(At, 0, 1); PG8_STAGE(PG8_SB(0, 0), b2, voffB); PG8_STAGE(PG8_SB(0, 1), b2 + hstep, voffB); PG8_STAGE(PG8_SA(0, 0), a2, voffA);
            PG8_WAIT_V(8); PG8_WAIT_L(0); PG8_BAR; PG8_MMA(1, 0, At, B0); PG8_MMA(1, 1, At, B1); PG8_BAR; PG8_SCHED;
            PG8_LDB(B0, 1, 0); PG8_LDB(B1, 1, 1); PG8_SCHED; PG8_LDA(At, 1, 0); PG8_STAGE(PG8_SA(0, 1), a2 + hstep, voffA);
            PG8_WAIT_V(8); PG8_WAIT_L(0); PG8_BAR; PG8_MMA(0, 0, At, B0); PG8_MMA(0, 1, At, B1); PG8_BAR; PG8_SCHED;
            PG8_LDA(At, 1, 1); PG8_STAGE(PG8_SB(1, 0), b3, voffB); PG8_STAGE(PG8_SB(1, 1), b3 + hstep, voffB); PG8_STAGE(PG8_SA(1, 0), a3, voffA);
            PG8_WAIT_V(8); PG8_WAIT_L(0); PG8_BAR; PG8_MMA(1, 0, At, B0); PG8_MMA(1, 1, At, B1); PG8_BAR; PG8_SCHED;
            } else {
            PG8_LDB(B0, 0, 0); PG8_SCHED; PG8_LDA(At, 0, 0); PG8_STAGE(PG8_SA(1, 1), a1 + hstep, voffA);
            PG8_WAIT_L(8); PG8_BAR; PG8_WAIT_L(0); PG8_MMA(0, 0, At, B0); PG8_BAR; PG8_SCHED;
            PG8_LDB(B1, 0, 1); PG8_STAGE(PG8_SB(0, 0), b2, voffB);
            PG8_BAR; PG8_WAIT_L(0); PG8_MMA(0, 1, At, B1); PG8_BAR;
            PG8_LDA(At, 0, 1); PG8_STAGE(PG8_SA(0, 0), a2, voffA);
            PG8_BAR; PG8_WAIT_L(0); PG8_MMA(1, 0, At, B0); PG8_BAR; PG8_SCHED;
            PG8_STAGE(PG8_SB(0, 1), b2 + hstep, voffB);
            PG8_WAIT_V(6); PG8_BAR; PG8_MMA(1, 1, At, B1); PG8_BAR;
            PG8_LDB(B0, 1, 0); PG8_SCHED; PG8_LDA(At, 1, 0); PG8_STAGE(PG8_SA(0, 1), a2 + hstep, voffA);
            PG8_WAIT_L(8); PG8_BAR; PG8_WAIT_L(0); PG8_MMA(0, 0, At, B0); PG8_BAR; PG8_SCHED;
            PG8_LDB(B1, 1, 1); PG8_STAGE(PG8_SB(1, 0), b3, voffB);
            PG8_BAR; PG8_WAIT_L(0); PG8_MMA(0, 1, At, B1); PG8_BAR;
            PG8_LDA(At, 1, 1); PG8_STAGE(PG8_SA(1, 0), a3, voffA);
            PG8_BAR; PG8_WAIT_L(0); PG8_MMA(1, 0, At, B0); PG8_BAR; PG8_SCHED;
            PG8_STAGE(PG8_SB(1, 1), b3 + hstep, voffB);
            PG8_WAIT_V(6); PG8_BAR; PG8_MMA(1, 1, At, B1); PG8_BAR;
            }
        }
        if constexpr (ALIGN_EPI) { if (wr == 0) PG8_BAR; }
        if constexpr (!Epi::AFTER_DRAIN) { E(acc, cur, wr, wc, fr, fq); S.done(cur); }
        if (!has_next) break;
#pragma unroll
        for (int a = 0; a < 2; ++a)
#pragma unroll
            for (int b = 0; b < 2; ++b)
#pragma unroll
                for (int m = 0; m < 4; ++m)
#pragma unroll
                    for (int n = 0; n < 2; ++n) acc[a][b][m][n] = (f32x4){0.f, 0.f, 0.f, 0.f};
        cur = nxt; cA = nA; cB = nB; ++ui;
        if constexpr (ALIGN_EPI) { if (wr == 1) PG8_BAR; }
    }
    PG8_WAIT_V(0);
    if constexpr (!ALIGN_EPI) { if (wr == 0) PG8_BAR; }
    PG8_BAR;
    if constexpr (Epi::AFTER_DRAIN) { E.fused(acc, cur, wr, wc, fr, fq, lds, wid, lane); S.done(cur); }
#undef PG8_SA
#undef PG8_SB
#undef PG8_STAGE
#undef PG8_LDA
#undef PG8_LDB
#undef PG8_MMA
#undef PG8_WAIT_V
#undef PG8_WAIT_L
#undef PG8_BAR
#undef PG8_SCHED
}
}

#define LAS __attribute__((address_space(3)))
typedef unsigned short bf16_t;
typedef short bf16x8 __attribute__((ext_vector_type(8)));
typedef short s16x4 __attribute__((ext_vector_type(4)));
typedef float f32x4 __attribute__((ext_vector_type(4)));
typedef float f32x2 __attribute__((ext_vector_type(2)));
typedef float f32x16 __attribute__((ext_vector_type(16)));
typedef unsigned u32x4 __attribute__((ext_vector_type(4)));
typedef unsigned u32x2 __attribute__((ext_vector_type(2)));

constexpr int M = 8192, DM = 2048, FF = 5632;
constexpr float EPS = 1e-6f;
constexpr float LOG2E = 1.4426950408889634f;
constexpr float QSCALE = 0.08838834764831845f * LOG2E;
constexpr int NTHREADS = 512, NWAVES = 8;

typedef __bf16 bf16x2_t __attribute__((ext_vector_type(2)));
__device__ __forceinline__ unsigned cvtpk(float lo, float hi) { f32x2 v = {lo, hi}; bf16x2_t b = __builtin_convertvector(v, bf16x2_t); return __builtin_bit_cast(unsigned, b); }
__device__ __forceinline__ float bf2f(unsigned short v) { return __uint_as_float((unsigned)v << 16); }
__device__ __forceinline__ float bflo(unsigned w) { return __uint_as_float(w << 16); }
__device__ __forceinline__ float bfhi(unsigned w) { return __uint_as_float(w & 0xffff0000u); }
__device__ __forceinline__ unsigned short f2bf(float f) { return (unsigned short)(cvtpk(f, 0.f) & 0xffffu); }
__device__ __forceinline__ float wave_sum(float v) {
#pragma unroll
    for (int o = 1; o < 64; o <<= 1) v += shx(v, o);
    return v;
}
__device__ __forceinline__ float sigmoid_f(float x) { return __builtin_amdgcn_rcpf(1.f + __expf(-x)); }
__device__ __forceinline__ float silu_m(float x) { return x * __builtin_amdgcn_rcpf(1.f + __expf(-x)); }
__device__ __forceinline__ float softplus_f(float x) { return fmaxf(x, 0.f) + log1pf(__expf(-fabsf(x))); }
__device__ __forceinline__ float logsigmoid_f(float x) { return fminf(x, 0.f) - log1pf(__expf(-fabsf(x))); }

struct CvtItem { f32x4 v[16]; };
__device__ __forceinline__ void cvt_load(CvtItem& it, const float* __restrict__ W, int ldw, int c0, int nvalid, int k0, int lane) {
    const int cc = 4 * (lane & 15); const float* wp = W + (size_t)(k0 + (lane >> 4)) * ldw + c0 + cc;
#pragma unroll
    for (int i = 0; i < 16; ++i) { it.v[i] = (f32x4){0.f, 0.f, 0.f, 0.f}; if (cc < nvalid) it.v[i] = *(const f32x4*)(wp + (size_t)(4 * i) * ldw); }
}
__device__ __forceinline__ void cvt_finish(const CvtItem& it, int nvalid, int k0, bf16_t* __restrict__ WT, int K, int drow0, LAS float* scr, int lane) {
    const int cc = 4 * (lane & 15);
#pragma unroll
    for (int i = 0; i < 16; ++i) { const int kk = 4 * i + (lane >> 4);
        LAS float* s = scr + kk * 65 + cc; s[0] = it.v[i][0]; s[1] = it.v[i][1]; s[2] = it.v[i][2]; s[3] = it.v[i][3]; }
    asm volatile("s_waitcnt lgkmcnt(0)" ::: "memory");
    const int c = lane & 7;
#pragma unroll
    for (int j = 0; j < 8; ++j) { const int n = 8 * j + (lane >> 3); const LAS float* s = scr + (8 * c) * 65 + n;
        u32x4 o; o.x = cvtpk(s[0], s[65]); o.y = cvtpk(s[2 * 65], s[3 * 65]); o.z = cvtpk(s[4 * 65], s[5 * 65]); o.w = cvtpk(s[6 * 65], s[7 * 65]);
        if (n < nvalid) *(u32x4*)(WT + (size_t)(drow0 + n) * K + k0 + 8 * c) = o; }
    asm volatile("s_waitcnt lgkmcnt(0)" ::: "memory");
}
__device__ __forceinline__ void cvt_matrix(const float* W, int ldw, int col0, int ncols, int K, bf16_t* WT, int dmode, int drow_off, LAS float* scr, int gw, int ngw, int lane) {
    const int nb = (ncols + 63) >> 6, items = (K >> 6) * nb;
#define CVT_DECODE(it_) const int kb = (it_) / nb, nbk = (it_) - kb * nb, n0 = nbk << 6; const int nvalid = (ncols - n0) < 64 ? (ncols - n0) : 64; \
        const int drow0 = dmode == 0 ? drow_off + n0 : ((n0 >> 7) << 8) + (n0 & 127) + (dmode == 2 ? 128 : 0);
    CvtItem A, B;
    int it = gw;
    if (it < items) { CVT_DECODE(it) (void)drow0; cvt_load(A, W, ldw, col0 + n0, nvalid, kb << 6, lane); }
    for (; it < items; it += 2 * ngw) {
        if (it + ngw < items) { CVT_DECODE(it + ngw) (void)drow0; cvt_load(B, W, ldw, col0 + n0, nvalid, kb << 6, lane); }
        { CVT_DECODE(it) cvt_finish(A, nvalid, kb << 6, WT, K, drow0, scr, lane); }
        if (it + 2 * ngw < items) { CVT_DECODE(it + 2 * ngw) (void)drow0; cvt_load(A, W, ldw, col0 + n0, nvalid, kb << 6, lane); }
        if (it + ngw < items) { CVT_DECODE(it + ngw) cvt_finish(B, nvalid, kb << 6, WT, K, drow0, scr, lane); }
    }
#undef CVT_DECODE
}

template <bool OUTF, bool COPY = false> __device__ __forceinline__ void norm_rows(const float* __restrict__ X, const float* __restrict__ w, bf16_t* __restrict__ Ob, float* __restrict__ Of, int gw, int ngw, int lane, float* __restrict__ Cp = nullptr) {
    for (int m0 = gw * 4; m0 < M; m0 += ngw * 4) {
        f32x4 v[4][8]; float s[4] = {0.f, 0.f, 0.f, 0.f};
#pragma unroll
        for (int q = 0; q < 4; ++q) { const f32x4* xr = (const f32x4*)(X + (size_t)(m0 + q) * DM) + lane;
#pragma unroll
            for (int j = 0; j < 8; ++j) v[q][j] = xr[64 * j]; }
#pragma unroll
        for (int q = 0; q < 4; ++q) { const int m = m0 + q;
#pragma unroll
            for (int j = 0; j < 8; ++j) { s[q] += (v[q][j][0] * v[q][j][0] + v[q][j][1] * v[q][j][1]) + (v[q][j][2] * v[q][j][2] + v[q][j][3] * v[q][j][3]);
                if (COPY) *((f32x4*)(Cp + (size_t)m * DM) + lane + 64 * j) = v[q][j]; }
            const float r = rsqrtf(wave_sum(s[q]) * (1.f / DM) + EPS);
#pragma unroll
            for (int j = 0; j < 8; ++j) { const f32x4 ww = *((const f32x4*)w + lane + 64 * j); const f32x4 o = v[q][j] * r * ww;
                if (OUTF) *((f32x4*)(Of + (size_t)m * DM) + lane + 64 * j) = o;
                else { u32x2 p; p.x = cvtpk(o[0], o[1]); p.y = cvtpk(o[2], o[3]); *((u32x2*)(Ob + (size_t)m * DM) + lane + 64 * j) = p; } } }
    }
}

template <bool OUTF, int R = 4> __device__ __forceinline__ void norm_rows_b(const bf16_t* __restrict__ X, const float* __restrict__ w, bf16_t* __restrict__ Ob, float* __restrict__ Of, int gw, int ngw, int lane) {
    for (int m0 = gw * R; m0 < M; m0 += ngw * R) {
        u32x4 v[R][4];
#pragma unroll
        for (int q = 0; q < R; ++q)
#pragma unroll
            for (int j = 0; j < 4; ++j) v[q][j] = *(const u32x4*)(X + (size_t)(m0 + q) * DM + j * 512 + lane * 8);
#pragma unroll
        for (int q = 0; q < R; ++q) { const int m = m0 + q; float f[4][8]; float s = 0.f;
#pragma unroll
            for (int j = 0; j < 4; ++j) { const u32x4 x = v[q][j]; f[j][0] = bflo(x.x); f[j][1] = bfhi(x.x); f[j][2] = bflo(x.y); f[j][3] = bfhi(x.y); f[j][4] = bflo(x.z); f[j][5] = bfhi(x.z); f[j][6] = bflo(x.w); f[j][7] = bfhi(x.w);
#pragma unroll
                for (int i = 0; i < 8; ++i) s += f[j][i] * f[j][i]; }
            const float r = rsqrtf(wave_sum(s) * (1.f / DM) + EPS);
#pragma unroll
            for (int j = 0; j < 4; ++j) { const f32x4 w0 = *(const f32x4*)(w + j * 512 + lane * 8), w1 = *(const f32x4*)(w + j * 512 + lane * 8 + 4);
                const f32x4 o0 = (f32x4){f[j][0], f[j][1], f[j][2], f[j][3]} * r * w0, o1 = (f32x4){f[j][4], f[j][5], f[j][6], f[j][7]} * r * w1;
                if (OUTF) { *(f32x4*)(Of + (size_t)m * DM + j * 512 + lane * 8) = o0; *(f32x4*)(Of + (size_t)m * DM + j * 512 + lane * 8 + 4) = o1; }
                else { u32x4 p; p.x = cvtpk(o0[0], o0[1]); p.y = cvtpk(o0[2], o0[3]); p.z = cvtpk(o1[0], o1[1]); p.w = cvtpk(o1[2], o1[3]); *(u32x4*)(Ob + (size_t)m * DM + j * 512 + lane * 8) = p; } } }
    }
}

namespace att {
constexpr int NW = 8, QBLK = 32, KVBLK = 64;
constexpr int SHM_V = 16384, SHM_K = 16384;
constexpr int OFF_K = 2 * SHM_V, OFF_WS = OFF_K + 2 * SHM_K, OFF_CK = OFF_WS + NW * 64 * 4, LDS_ATT = OFF_CK + 2 * 256;
constexpr float THR = 8.f;
#define KSWZ(row, colB) ((row) * 256 + ((colB) ^ (((row) & 7) << 4)))
#define SBAR() __builtin_amdgcn_sched_barrier(0)
__device__ __forceinline__ int crow(int r, int hi) { return (r & 3) + 8 * (r >> 2) + 4 * hi; }
template <int MODE> __device__ __forceinline__ void maskp(f32x16& p0, f32x16& p1, int t, int NT, int qb, int wid, int qrel, int hi) {
    const float NEG = -INFINITY;
    if (MODE == 0) { if (t > 4 * qb + (wid >> 1)) {
#pragma unroll
            for (int r = 0; r < 16; ++r) { p0[r] = NEG; p1[r] = NEG; } } }
    else { if (t >= NT - 4) { const int d = qrel - (64 * (t - (NT - 4)) + 4 * hi);
#pragma unroll
            for (int r = 0; r < 16; ++r) { const int c = (r & 3) + 8 * (r >> 2); p0[r] = (c > d) ? NEG : p0[r]; p1[r] = (c + 32 > d) ? NEG : p1[r]; } } }
}
__device__ __forceinline__ void partialSM(f32x16& p0, f32x16& p1, float& m_reg, float& alpha) {
    float pmax = p0[0];
#pragma unroll
    for (int r = 1; r < 16; ++r) pmax = fmaxf(pmax, p0[r]);
#pragma unroll
    for (int r = 0; r < 16; ++r) pmax = fmaxf(pmax, p1[r]);
    { auto rr = __builtin_amdgcn_permlane32_swap(__float_as_uint(pmax), __float_as_uint(pmax), false, false);
      pmax = fmaxf(__uint_as_float(rr[0]), __uint_as_float(rr[1])); }
    float mn;
    if (__builtin_expect(__all(pmax - m_reg <= THR), 1)) { mn = m_reg; alpha = 1.f; }
    else { mn = fmaxf(m_reg, pmax); alpha = __builtin_amdgcn_exp2f(m_reg - mn); m_reg = mn; }
#pragma unroll
    for (int r = 0; r < 16; ++r) p0[r] = p0[r] - mn;
#pragma unroll
    for (int r = 0; r < 16; ++r) p1[r] = p1[r] - mn;
#pragma unroll
    for (int r = 0; r < 16; ++r) p0[r] = __builtin_amdgcn_exp2f(p0[r]);
}
__device__ __forceinline__ void finishSM(f32x16& p0, f32x16& p1, float alpha, float& l_reg, bf16x8& pa0, bf16x8& pa1, bf16x8& pa2, bf16x8& pa3) {
#pragma unroll
    for (int r = 0; r < 16; ++r) p1[r] = __builtin_amdgcn_exp2f(p1[r]);
    float ps = 0;
#pragma unroll
    for (int r = 0; r < 16; ++r) ps += p0[r];
#pragma unroll
    for (int r = 0; r < 16; ++r) ps += p1[r];
    { auto rr = __builtin_amdgcn_permlane32_swap(__float_as_uint(ps), __float_as_uint(ps), false, false);
      ps = __uint_as_float(rr[0]) + __uint_as_float(rr[1]); }
    l_reg = l_reg * alpha + ps;
#define PK4(P, BASE, OUT) do { unsigned a0 = cvtpk(P[BASE + 0], P[BASE + 1]), a1 = cvtpk(P[BASE + 2], P[BASE + 3]);   \
    unsigned b0 = cvtpk(P[BASE + 4], P[BASE + 5]), b1 = cvtpk(P[BASE + 6], P[BASE + 7]);                              \
    auto r0 = __builtin_amdgcn_permlane32_swap(a0, b0, false, false); auto r1 = __builtin_amdgcn_permlane32_swap(a1, b1, false, false); \
    u32x4 w = {r0[0], r1[0], r0[1], r1[1]}; OUT = *reinterpret_cast<bf16x8*>(&w); } while (0)
    PK4(p0, 0, pa0); PK4(p0, 8, pa1); PK4(p1, 0, pa2); PK4(p1, 8, pa3);
#undef PK4
}
template <int MODE> __device__ __forceinline__ void qkt(f32x16& p0, f32x16& p1, const char* Ks, const float* ckl, const bf16x8* qr, int r32, int hi) {
    if (MODE == 1) {
#pragma unroll
        for (int i = 0; i < 4; ++i) { const f32x4 a = *(const f32x4*)(ckl + 8 * i + 4 * hi), b = *(const f32x4*)(ckl + 32 + 8 * i + 4 * hi);
            p0[4 * i] = a[0]; p0[4 * i + 1] = a[1]; p0[4 * i + 2] = a[2]; p0[4 * i + 3] = a[3];
            p1[4 * i] = b[0]; p1[4 * i + 1] = b[1]; p1[4 * i + 2] = b[2]; p1[4 * i + 3] = b[3]; }
    } else { p0 = f32x16{}; p1 = f32x16{}; }
#pragma unroll
    for (int d0 = 0; d0 < 8; ++d0) { const int cb = (d0 * 16 + hi * 8) * 2;
        bf16x8 b0 = *reinterpret_cast<const bf16x8*>(Ks + KSWZ(r32, cb));
        bf16x8 b1 = *reinterpret_cast<const bf16x8*>(Ks + KSWZ(32 + r32, cb));
        p0 = __builtin_amdgcn_mfma_f32_32x32x16_bf16(b0, qr[d0], p0, 0, 0, 0);
        p1 = __builtin_amdgcn_mfma_f32_32x32x16_bf16(b1, qr[d0], p1, 0, 0, 0); }
}
__device__ __forceinline__ int v_st(int k, int c) { const int kk = (k & ~0xC) | ((k & 4) << 1) | ((k & 8) >> 1); return ((kk >> 3) * 4 + (c >> 5)) * 512 + ((kk & 7) * 32 + (c & 31)) * 2; }
__device__ __forceinline__ int v_rd_base(int lane) { return ((lane & 3) << 3) | (((lane >> 2) & 3) << 6) | (((lane >> 4) & 1) << 5) | (((lane >> 5) & 1) << 8); }
constexpr int v_rd_off(int d0, int ks, int half) { return d0 * 512 + ks * 4096 + half * 2048; }
template <int OFF> __device__ __forceinline__ s16x4 tr_read(int vb) {
    s16x4 r; asm volatile("ds_read_b64_tr_b16 %0, %1 offset:%2" : "=&v"(r) : "v"(vb), "i"(OFF) : "memory"); return r;
}
template <int D0> __device__ __forceinline__ void pv_one(f32x16& od, int vb, bf16x8 pa0, bf16x8 pa1, bf16x8 pa2, bf16x8 pa3) {
    const s16x4 l0 = tr_read<v_rd_off(D0, 0, 0)>(vb), h0 = tr_read<v_rd_off(D0, 0, 1)>(vb), l1 = tr_read<v_rd_off(D0, 1, 0)>(vb), h1 = tr_read<v_rd_off(D0, 1, 1)>(vb);
    const s16x4 l2 = tr_read<v_rd_off(D0, 2, 0)>(vb), h2 = tr_read<v_rd_off(D0, 2, 1)>(vb), l3 = tr_read<v_rd_off(D0, 3, 0)>(vb), h3 = tr_read<v_rd_off(D0, 3, 1)>(vb);
    asm volatile("s_waitcnt lgkmcnt(0)" ::: "memory"); SBAR();
#define PK(L, H) (bf16x8){L[0], L[1], L[2], L[3], H[0], H[1], H[2], H[3]}
    od = __builtin_amdgcn_mfma_f32_32x32x16_bf16(pa0, PK(l0, h0), od, 0, 0, 0);
    od = __builtin_amdgcn_mfma_f32_32x32x16_bf16(pa1, PK(l1, h1), od, 0, 0, 0);
    od = __builtin_amdgcn_mfma_f32_32x32x16_bf16(pa2, PK(l2, h2), od, 0, 0, 0);
    od = __builtin_amdgcn_mfma_f32_32x32x16_bf16(pa3, PK(l3, h3), od, 0, 0, 0);
#undef PK
}
__device__ __forceinline__ void pv_d0(f32x16* o, int vb, bf16x8 pa0, bf16x8 pa1, bf16x8 pa2, bf16x8 pa3) {
    pv_one<0>(o[0], vb, pa0, pa1, pa2, pa3); pv_one<1>(o[1], vb, pa0, pa1, pa2, pa3); pv_one<2>(o[2], vb, pa0, pa1, pa2, pa3); pv_one<3>(o[3], vb, pa0, pa1, pa2, pa3);
}
template <int MODE, int LD, int SD>
__device__ __forceinline__ void attn_unit(const bf16_t* __restrict__ Qb, const bf16_t* __restrict__ Kh, const bf16_t* __restrict__ Vh, int qb,
                                          const float* __restrict__ nck, float* __restrict__ Of, bf16_t* __restrict__ Ob, const bf16_t* __restrict__ Gb, char* lds, int wv) {
    const int tid = tidw(wv), wid = wv, lane = tid & 63, r32 = lane & 31, hi = lane >> 5;
    char* V_lds = lds; char* K_lds = lds + OFF_K;
    float* ws = (float*)(lds + OFF_WS) + wid * 64; float* li_l = ws; float* al_l = ws + 32;
    float* ck_lds = (float*)(lds + OFF_CK);
    float m_reg = -1e30f, l_reg = 0; f32x16 o[4] = {}; bf16x8 qr[8];
    const bf16_t* Qw = Qb + (long)(wid * QBLK + r32) * LD + hi * 8;
#pragma unroll
    for (int d0 = 0; d0 < 8; ++d0) qr[d0] = *reinterpret_cast<const bf16x8*>(Qw + d0 * 16);
    const int sr = tid >> 4, sc = (tid & 15) * 8, vst0 = v_st(sr, sc), vst1 = v_st(32 + sr, sc);
    const int vb0 = (int)(uintptr_t)V_lds + v_rd_base(lane);
    struct { bf16x8 vs0, vs1, ks0, ks1; float ck; } sr_[SD];
#define SLOAD(i, k0) do { sr_[i].vs0 = *reinterpret_cast<const bf16x8*>(&Vh[(long)((k0) + sr) * LD + sc]); sr_[i].vs1 = *reinterpret_cast<const bf16x8*>(&Vh[(long)((k0) + 32 + sr) * LD + sc]); \
    sr_[i].ks0 = *reinterpret_cast<const bf16x8*>(&Kh[(long)((k0) + sr) * LD + sc]); sr_[i].ks1 = *reinterpret_cast<const bf16x8*>(&Kh[(long)((k0) + 32 + sr) * LD + sc]); \
    if (MODE == 1) { if (tid < 64) sr_[i].ck = nck[(k0) + tid]; } } while (0)
#define SWRITE(b, i) do { *(bf16x8*)(V_lds + (b) * SHM_V + vst0) = sr_[i].vs0;          \
    *(bf16x8*)(V_lds + (b) * SHM_V + vst1) = sr_[i].vs1; const int kc = sc * 2;               \
    *(bf16x8*)(K_lds + (b) * SHM_K + KSWZ(sr, kc)) = sr_[i].ks0;                       \
    *(bf16x8*)(K_lds + (b) * SHM_K + KSWZ(32 + sr, kc)) = sr_[i].ks1; \
    if (MODE == 1) { if (tid < 64) ck_lds[(b) * 64 + tid] = sr_[i].ck; } } while (0)
#define SWAIT() do { if (SD == 2) asm volatile("s_waitcnt vmcnt(4)" ::: "memory"); else asm volatile("s_waitcnt vmcnt(0)" ::: "memory"); } while (0)
#define RESC(a) do { if (__any((a) < 1.f)) { if (hi == 0) al_l[r32] = (a); asm volatile("s_waitcnt lgkmcnt(0)" ::: "memory"); \
    _Pragma("unroll") for (int d = 0; d < 4; ++d) _Pragma("unroll") for (int r = 0; r < 16; ++r) o[d][r] *= al_l[crow(r, hi)]; } } while (0)
    f32x16 pA0, pA1, pB0, pB1; float alA, alB; bf16x8 pa0, pa1, pa2, pa3; const int NT = 4 * qb + 4;
    const int qrel = wid * QBLK + r32;
    constexpr int SE = 0, SO = SD - 1;
    SLOAD(SE, 0); asm volatile("s_waitcnt vmcnt(0)" ::: "memory"); SWRITE(0, SE); __syncthreads();
    qkt<MODE>(pA0, pA1, K_lds, ck_lds, qr, r32, hi); maskp<MODE>(pA0, pA1, 0, NT, qb, wid, qrel, hi); partialSM(pA0, pA1, m_reg, alA);
    SLOAD(SO, KVBLK); if (SD == 2) { if (2 < NT) SLOAD(SE, 2 * KVBLK); }
    SWAIT(); SWRITE(1, SO); __syncthreads();
    for (int j = 1; j + 1 < NT; j += 2) {
        SBAR(); qkt<MODE>(pB0, pB1, K_lds + SHM_K, ck_lds + 64, qr, r32, hi); maskp<MODE>(pB0, pB1, j, NT, qb, wid, qrel, hi);
        finishSM(pA0, pA1, alA, l_reg, pa0, pa1, pa2, pa3); SBAR();
        SLOAD(SO, (j + SD) * KVBLK); SBAR();
        pv_d0(o, vb0, pa0, pa1, pa2, pa3); partialSM(pB0, pB1, m_reg, alB);
        __syncthreads(); SWAIT(); SWRITE(0, SE);
        RESC(alB); __syncthreads();
        SBAR(); qkt<MODE>(pA0, pA1, K_lds, ck_lds, qr, r32, hi); maskp<MODE>(pA0, pA1, j + 1, NT, qb, wid, qrel, hi);
        finishSM(pB0, pB1, alB, l_reg, pa0, pa1, pa2, pa3); SBAR();
        if (SD == 1 || j + 3 < NT) SLOAD(SE, (j + 1 + SD) * KVBLK); SBAR();
        pv_d0(o, vb0 + SHM_V, pa0, pa1, pa2, pa3); partialSM(pA0, pA1, m_reg, alA);
        __syncthreads(); SWAIT(); SWRITE(1, SO);
        RESC(alA); __syncthreads();
    }
    SBAR(); qkt<MODE>(pB0, pB1, K_lds + SHM_K, ck_lds + 64, qr, r32, hi); maskp<MODE>(pB0, pB1, NT - 1, NT, qb, wid, qrel, hi);
    finishSM(pA0, pA1, alA, l_reg, pa0, pa1, pa2, pa3); SBAR();
    pv_d0(o, vb0, pa0, pa1, pa2, pa3); partialSM(pB0, pB1, m_reg, alB);
    __syncthreads(); RESC(alB);
    finishSM(pB0, pB1, alB, l_reg, pa0, pa1, pa2, pa3); SBAR();
    pv_d0(o, vb0 + SHM_V, pa0, pa1, pa2, pa3);
    if (hi == 0) li_l[r32] = l_reg; asm volatile("s_waitcnt lgkmcnt(0)" ::: "memory");
    float rli[16];
#pragma unroll
    for (int r = 0; r < 16; ++r) rli[r] = __builtin_amdgcn_rcpf(li_l[crow(r, hi)]);
    if (MODE == 0) { float* Ow = Of + (long)(wid * QBLK) * 2048;
#pragma unroll
        for (int r = 0; r < 16; ++r) { const int orow = crow(r, hi);
#pragma unroll
            for (int d0 = 0; d0 < 4; ++d0) Ow[(long)orow * 2048 + d0 * 32 + r32] = o[d0][r] * rli[r]; } }
    else { bf16_t* Ow = Ob + (long)(wid * QBLK) * 2048; const bf16_t* Gw = Gb + (long)(wid * QBLK) * LD;
#pragma unroll
        for (int r = 0; r < 16; ++r) { const int orow = crow(r, hi);
#pragma unroll
            for (int d0 = 0; d0 < 4; ++d0) { const float g = bf2f(Gw[(long)orow * LD + d0 * 32 + r32]);
                Ow[(long)orow * 2048 + d0 * 32 + r32] = f2bf(o[d0][r] * rli[r] * sigmoid_f(g)); } } }
    __syncthreads();
#undef SLOAD
#undef SWRITE
#undef SWAIT
#undef RESC
}
#undef SBAR
}
#define LAS __attribute__((address_space(3)))
#define XB_TMO      128
#define XB_XCNT(j)  (256  + 64 * (j))
#define XB_XSUB(j)  (1280 + 64 * (j))
#define XB_XGEN(j)  (2304 + 64 * (j))
#define XB_TOP      3328
#define XB_TOPGEN   3392
#define XCD_BAR_WORDS 3456
#define XB_SPIN_CAP (1u << 18)

__device__ __forceinline__ unsigned xb_ld(unsigned* p)              { return __hip_atomic_load(p, __ATOMIC_RELAXED, __HIP_MEMORY_SCOPE_AGENT); }
__device__ __forceinline__ unsigned xb_add(unsigned* p, unsigned v) { return __hip_atomic_fetch_add(p, v, __ATOMIC_RELAXED, __HIP_MEMORY_SCOPE_AGENT); }
__device__ __forceinline__ unsigned xb_xcc_id() { return (unsigned)__builtin_amdgcn_s_getreg((3 << 11) | 20) & 0xFu; }
#define XB_SPIN(cond, bar) do { unsigned _sp = 0; while (cond) { __builtin_amdgcn_s_sleep(1); \
    if ((++_sp & 255u) == 0u) { if (xb_ld(&(bar)[XB_TMO])) break; if (_sp > XB_SPIN_CAP) { atomicAdd(&(bar)[XB_TMO], 1u); break; } } } } while (0)

struct XcdBarrier {
    unsigned* bar; unsigned x;
    volatile LAS unsigned* st;
};

__device__ __forceinline__ XcdBarrier xcd_barrier_post(unsigned* bar, volatile LAS unsigned* st) {
    XcdBarrier b; b.bar = bar; b.x = xb_xcc_id(); b.st = st;
    if (threadIdx.x == 0) (void)xb_add(&bar[XB_XCNT(b.x)], 1u);
    return b;
}
__device__ __forceinline__ void xcd_barrier_complete(unsigned* bar, unsigned x, unsigned& nloc, unsigned& nx) {
    const unsigned G = gridDim.x * gridDim.y * gridDim.z;
    unsigned sum, cnt, mine, sp = 0u;
    for (;;) {
        sum = 0u; cnt = 0u; mine = 0u;
#pragma unroll
        for (unsigned j = 0; j < 16; ++j) { const unsigned c = xb_ld(&bar[XB_XCNT(j)]); sum += c; cnt += (c > 0u) ? 1u : 0u; mine = (j == x) ? c : mine; }
        if (sum == G) break;
        __builtin_amdgcn_s_sleep(1);
        if ((++sp & 255u) == 0u) { if (xb_ld(&bar[XB_TMO])) break; if (sp > XB_SPIN_CAP) { atomicAdd(&bar[XB_TMO], 1u); break; } }
    }
    nloc = mine > 0u ? mine : 1u; nx = cnt > 0u ? cnt : 1u;
}

__device__ __forceinline__ void xcd_barrier(const XcdBarrier& b) {
    asm volatile("s_waitcnt vmcnt(0)" ::: "memory");
    __syncthreads();
    if (threadIdx.x == 0) {
        unsigned* bar = b.bar;
        __builtin_amdgcn_s_waitcnt(0);
        unsigned nloc = b.st[0], nx = b.st[1];
        if (nloc == 0u) { xcd_barrier_complete(bar, b.x, nloc, nx); b.st[0] = nloc; b.st[1] = nx; }
        const unsigned old = xb_add(&bar[XB_XSUB(b.x)], 1u);
        const unsigned gen = old / nloc;
        if (old + 1u == (gen + 1u) * nloc) {
            __builtin_amdgcn_fence(__ATOMIC_RELEASE, "agent");
            asm volatile("s_waitcnt vmcnt(0)" ::: "memory");
            const unsigned og = xb_add(&bar[XB_TOP], 1u);
            const unsigned tg = og / nx;
            if (og + 1u == (tg + 1u) * nx) xb_add(&bar[XB_TOPGEN], 1u);
            else XB_SPIN(xb_ld(&bar[XB_TOPGEN]) == tg, bar);
            __builtin_amdgcn_fence(__ATOMIC_ACQUIRE, "agent");
            xb_add(&bar[XB_XGEN(b.x)], 1u);
            asm volatile("s_waitcnt vmcnt(0)" ::: "memory");
        } else {
            XB_SPIN(xb_ld(&bar[XB_XGEN(b.x)]) == gen, bar);
            __builtin_amdgcn_fence(__ATOMIC_ACQUIRE, "agent");
            asm volatile("s_waitcnt vmcnt(0)" ::: "memory");
        }
    }
    __syncthreads();
}

__device__ __forceinline__ void fox_qknorm(bf16_t* P, const float* qn, const float* kn, int gw, int ngw, int lane) {
    const int dl = (lane & 15) * 8;
    const f32x4 q0 = *(const f32x4*)(qn + dl), q1 = *(const f32x4*)(qn + dl + 4), k0 = *(const f32x4*)(kn + dl), k1 = *(const f32x4*)(kn + dl + 4);
    for (int it0 = gw * 8; it0 < 2 * M; it0 += ngw * 8) {
        u32x4 xs[8][4];
#pragma unroll
        for (int q = 0; q < 8; ++q) { const int it = it0 + q; const bf16_t* row = P + (size_t)(it >> 1) * 8192 + (it & 1) * 2048;
#pragma unroll
            for (int j = 0; j < 4; ++j) xs[q][j] = *(const u32x4*)(row + j * 512 + lane * 8); }
#pragma unroll
        for (int q = 0; q < 8; ++q) { const int it = it0 + q, isk = it & 1; bf16_t* row = P + (size_t)(it >> 1) * 8192 + isk * 2048;
            const f32x4 w0 = isk ? k0 : q0, w1 = isk ? k1 : q1; const float mul = isk ? 1.f : QSCALE;
#pragma unroll
            for (int j = 0; j < 4; ++j) { const u32x4 x = xs[q][j];
                float f[8] = {bflo(x.x), bfhi(x.x), bflo(x.y), bfhi(x.y), bflo(x.z), bfhi(x.z), bflo(x.w), bfhi(x.w)};
                float s = 0.f;
#pragma unroll
                for (int i = 0; i < 8; ++i) s += f[i] * f[i];
                s += shx(s, 1); s += shx(s, 2); s += shx(s, 4); s += shx(s, 8);
                const float r = rsqrtf(s * (1.f / 128.f) + EPS) * mul;
                u32x4 o; o.x = cvtpk(f[0] * r * w0[0], f[1] * r * w0[1]); o.y = cvtpk(f[2] * r * w0[2], f[3] * r * w0[3]);
                o.z = cvtpk(f[4] * r * w1[0], f[5] * r * w1[1]); o.w = cvtpk(f[6] * r * w1[2], f[7] * r * w1[3]);
                *(u32x4*)(row + j * 512 + lane * 8) = o; } } }
}
__device__ __forceinline__ void fox_cumsum(const float* XF  , const float* bias, float* NCK, int hd, LAS float* scr, int tid) {
    const float b = bias[hd]; float v[16]; float run = 0.f;
    float fs[16];
#pragma unroll
    for (int i = 0; i < 16; ++i) fs[i] = 0.f;
#pragma unroll
    for (int ks = 0; ks < 8; ++ks) { const f32x4* p = (const f32x4*)(XF + (size_t)ks * M * 64 + (size_t)hd * M + tid * 16);
#pragma unroll
        for (int q = 0; q < 4; ++q) { const f32x4 t = p[q]; fs[4 * q] += t[0]; fs[4 * q + 1] += t[1]; fs[4 * q + 2] += t[2]; fs[4 * q + 3] += t[3]; } }
#pragma unroll
    for (int i = 0; i < 16; ++i) { run += logsigmoid_f(fs[i] + b); v[i] = run; }
    float inc = run; const int lane = tid & 63, wid = tid >> 6;
#pragma unroll
    for (int o = 1; o < 64; o <<= 1) { const float t = shup(inc, o); if (lane >= o) inc += t; }
    if (lane == 63) scr[wid] = inc;
    __syncthreads();
    float base = inc - run;
    for (int w = 0; w < wid; ++w) base += scr[w];
#pragma unroll
    for (int i = 0; i < 16; ++i) NCK[(size_t)hd * M + tid * 16 + i] = -(base + v[i]) * LOG2E;
    __syncthreads();
}
__device__ __forceinline__ void diff_combine(const float* O0, const float* O1, const float* q1, const float* k1, const float* q2, const float* k2, const float* sub, float lam_init,
                                             bf16_t* MIX, int gw, int ngw, int lane) {
    const float s1 = wave_sum(q1[lane] * k1[lane] + q1[lane + 64] * k1[lane + 64]), s2 = wave_sum(q2[lane] * k2[lane] + q2[lane + 64] * k2[lane + 64]);
    const float lam = __expf(s1) - __expf(s2) + lam_init; const float post = 1.f - lam_init;
    const f32x4 sw = *((const f32x4*)sub + lane);
    for (int it0 = gw * 8; it0 < M * 8; it0 += ngw * 8) {
        f32x4 a[8], b[8];
#pragma unroll
        for (int q = 0; q < 8; ++q) { const size_t off = (size_t)(it0 + q) * 256 + lane * 4; a[q] = *(const f32x4*)(O0 + off); b[q] = *(const f32x4*)(O1 + off); }
#pragma unroll
        for (int q = 0; q < 8; ++q) { const size_t off = (size_t)(it0 + q) * 256 + lane * 4; const f32x4 d = a[q] - lam * b[q];
            const float ss = wave_sum((d[0] * d[0] + d[1] * d[1]) + (d[2] * d[2] + d[3] * d[3]));
            const float r = rsqrtf(ss * (1.f / 256.f) + EPS) * post; const f32x4 o = d * r * sw;
            u32x2 p; p.x = cvtpk(o[0], o[1]); p.y = cvtpk(o[2], o[3]); *(u32x2*)(MIX + off) = p; } }
}
__device__ __forceinline__ void gdn_post(const bf16_t* OG, const bf16_t* Z, const float* onw, bf16_t* MIX, int gw, int ngw, int lane) {
    const int dl = (lane & 15) * 8; const f32x4 w0 = *(const f32x4*)(onw + dl), w1 = *(const f32x4*)(onw + dl + 4);
    const float w[8] = {w0[0], w0[1], w0[2], w0[3], w1[0], w1[1], w1[2], w1[3]};
    for (int it0 = gw * 8; it0 < M * 8; it0 += ngw * 8) {
        u32x4 xs[8], zs[8];
#pragma unroll
        for (int q = 0; q < 8; ++q) { const int it = it0 + q; const size_t off = (size_t)it * 512 + lane * 8;
            const int tok_ = it >> 3, hv_ = (it & 7) * 4 + (lane >> 4), j_ = lane & 15;
            xs[q] = *(const u32x4*)(OG + ((size_t)(((tok_ >> 6) * 32 + hv_) * 8 + (j_ >> 1)) * 64 + (tok_ & 63)) * 16 + 8 * (j_ & 1)); zs[q] = *(const u32x4*)(Z + off); }
#pragma unroll
        for (int q = 0; q < 8; ++q) { const size_t off = (size_t)(it0 + q) * 512 + lane * 8; const u32x4 x = xs[q], z = zs[q];
            const float f[8] = {bflo(x.x), bfhi(x.x), bflo(x.y), bfhi(x.y), bflo(x.z), bfhi(x.z), bflo(x.w), bfhi(x.w)};
            const float g[8] = {bflo(z.x), bfhi(z.x), bflo(z.y), bfhi(z.y), bflo(z.z), bfhi(z.z), bflo(z.w), bfhi(z.w)};
            float s = 0.f;
#pragma unroll
            for (int i = 0; i < 8; ++i) s += f[i] * f[i];
            s += shx(s, 1); s += shx(s, 2); s += shx(s, 4); s += shx(s, 8);
            const float r = rsqrtf(s * (1.f / 128.f) + EPS); float o[8];
#pragma unroll
            for (int i = 0; i < 8; ++i) o[i] = f[i] * r * w[i] * silu_m(g[i]);
            u32x4 p; p.x = cvtpk(o[0], o[1]); p.y = cvtpk(o[2], o[3]); p.z = cvtpk(o[4], o[5]); p.w = cvtpk(o[6], o[7]);
            *(u32x4*)(MIX + off) = p; } }
}

namespace gdn {
constexpr int QSTR = 136;
constexpr int OFF_QS = 0, OFF_KS = OFF_QS + 64 * QSTR * 2, OFF_VS = OFF_KS + 64 * QSTR * 2, OFF_KK = OFF_VS + 64 * 256 * 2, OFF_QK = OFF_KK + 16384, OFF_T1 = OFF_QK + 16384,
              OFF_SM = OFF_T1 + 16384, LDS_PREP = OFF_SM + 6 * 64 * 4;
struct TRow { f32x4 t[16]; };
template <int I> __device__ __forceinline__ void load_trow(TRow& R, const LAS float* T) {
#pragma unroll
    for (int jb = 0; jb < 16; ++jb) if (4 * jb < I) R.t[jb] = *(const LAS f32x4*)(T + I * 64 + 4 * jb);
}
struct TRow8 { f32x4 t[8]; };
template <int I> __device__ __forceinline__ void load_trow8(TRow8& R, const LAS float* T) {
#pragma unroll
    for (int jb = 0; jb < 8; ++jb) if (4 * jb < I) R.t[jb] = *(const LAS f32x4*)(T + I * 64 + 4 * jb);
}
template <int I> __device__ __forceinline__ void solve_rows(f32x2 (&xp)[32], const LAS float* T, const TRow8& cur) {
    if constexpr (I < 64) {
        TRow8 nxt;
        if constexpr (I + 1 < 64) load_trow8<I + 1>(nxt, T);
        asm volatile("" ::: "memory"); __builtin_amdgcn_sched_barrier(0);
        f32x2 r2 = {xp[I >> 1][I & 1], 0.f};
#pragma unroll
        for (int jb = 0; jb < 8; ++jb) if (4 * jb < I) {
            const f32x2 tlo = {cur.t[jb][0], cur.t[jb][1]}, thi = {cur.t[jb][2], cur.t[jb][3]};
            r2 -= tlo * xp[2 * jb];
            if (4 * jb + 2 < I) r2 -= thi * xp[2 * jb + 1]; }
#pragma unroll
        for (int jb = 8; jb < 16; ++jb) if (4 * jb < I) {
            const f32x4 tr = *(const LAS f32x4*)(T + I * 64 + 4 * jb);
            const f32x2 tlo = {tr[0], tr[1]}, thi = {tr[2], tr[3]};
            r2 -= tlo * xp[2 * jb];
            if (4 * jb + 2 < I) r2 -= thi * xp[2 * jb + 1]; }
        xp[I >> 1][I & 1] = r2[0] + r2[1];
        solve_rows<I + 1>(xp, T, nxt);
    }
}
__device__ __forceinline__ void prep_unit(int hk, int n, const bf16_t* __restrict__ RAW, const float* __restrict__ XF, const float* __restrict__ convw, const float* __restrict__ a_log, const float* __restrict__ dt_bias,
                                          bf16_t* __restrict__ QN, bf16_t* __restrict__ KT, bf16_t* __restrict__ UT, bf16_t* __restrict__ NWB, bf16_t* __restrict__ INTRA, float* __restrict__ GCG, LAS unsigned char* lds, int wv) {
    const int tid = tidw(wv), wid = wv, lane = tid & 63, t0 = n * 64;
    LAS bf16_t* QS = (LAS bf16_t*)(lds + OFF_QS); LAS bf16_t* KS = (LAS bf16_t*)(lds + OFF_KS); LAS bf16_t* VS = (LAS bf16_t*)(lds + OFF_VS);
    LAS float* KK = (LAS float*)(lds + OFF_KK); LAS float* QK = (LAS float*)(lds + OFF_QK); LAS float* T1 = (LAS float*)(lds + OFF_T1);
    LAS float* BETA = (LAS float*)(lds + OFF_SM); LAS float* GC = BETA + 128; LAS float* EGC = GC + 128;
    { const int part = lane >> 4, cg = lane & 15;
      const int ch = (part == 0 ? hk * 128 : part == 1 ? 2048 + hk * 128 : 4096 + (2 * hk + (part - 2)) * 128) + cg * 8;
      float cw[4][8];
#pragma unroll
      for (int j = 0; j < 4; ++j) { const f32x4 a = *(const f32x4*)(convw + (size_t)j * 8192 + ch), b = *(const f32x4*)(convw + (size_t)j * 8192 + ch + 4);
          cw[j][0] = a[0]; cw[j][1] = a[1]; cw[j][2] = a[2]; cw[j][3] = a[3]; cw[j][4] = b[0]; cw[j][5] = b[1]; cw[j][6] = b[2]; cw[j][7] = b[3]; }
      float x0[8], x1[8], x2[8], x3[8];
      const int tb = t0 + wid * 8;
#define LDROW(dst, t) do { if ((t) >= 0) { const u32x4 w_ = *(const u32x4*)(RAW + (size_t)(t) * 8192 + ch); dst[0] = bflo(w_.x); dst[1] = bfhi(w_.x); dst[2] = bflo(w_.y); dst[3] = bfhi(w_.y); \
          dst[4] = bflo(w_.z); dst[5] = bfhi(w_.z); dst[6] = bflo(w_.w); dst[7] = bfhi(w_.w); } else { _Pragma("unroll") for (int i_ = 0; i_ < 8; ++i_) dst[i_] = 0.f; } } while (0)
      LDROW(x0, tb - 3); LDROW(x1, tb - 2); LDROW(x2, tb - 1);
#pragma unroll
      for (int i = 0; i < 8; ++i) {
          LDROW(x3, tb + i);
          float y[8]; float ss = 0.f;
#pragma unroll
          for (int c = 0; c < 8; ++c) { const float a = cw[0][c] * x0[c] + cw[1][c] * x1[c] + cw[2][c] * x2[c] + cw[3][c] * x3[c]; y[c] = silu_m(a); ss += y[c] * y[c]; }
          ss += shx(ss, 1); ss += shx(ss, 2); ss += shx(ss, 4); ss += shx(ss, 8);
          float mul = 1.f; if (part < 2) mul = rsqrtf(ss + EPS) * (part == 0 ? 0.08838834764831845f : 1.f);
          u32x4 o; o.x = cvtpk(y[0] * mul, y[1] * mul); o.y = cvtpk(y[2] * mul, y[3] * mul); o.z = cvtpk(y[4] * mul, y[5] * mul); o.w = cvtpk(y[6] * mul, y[7] * mul);
          const int tt = wid * 8 + i;
          if (part == 0) *(LAS u32x4*)(QS + tt * QSTR + cg * 8) = o; else if (part == 1) *(LAS u32x4*)(KS + tt * QSTR + cg * 8) = o; else *(LAS u32x4*)(VS + tt * 256 + (part - 2) * 128 + cg * 8) = o;
#pragma unroll
          for (int c = 0; c < 8; ++c) { x0[c] = x1[c]; x1[c] = x2[c]; x2[c] = x3[c]; }
      }
#undef LDROW
    }
    if (tid < 128) { const int j = tid >> 6, i = tid & 63, hv = 2 * hk + j; const float* xr = XF + (size_t)(t0 + i) * 64;
        float xb = 0.f, xa = 0.f;
#pragma unroll
        for (int ks = 0; ks < 8; ++ks) { xb += xr[(size_t)ks * M * 64 + hv]; xa += xr[(size_t)ks * M * 64 + 32 + hv]; }
        const float be = sigmoid_f(xb); const float g = -__expf(a_log[hv]) * softplus_f(xa + dt_bias[hv]);
        float inc = g;
#pragma unroll
        for (int o = 1; o < 64; o <<= 1) { const float t = shup(inc, o); if (i >= o) inc += t; }
        BETA[j * 64 + i] = be; GC[j * 64 + i] = inc; EGC[j * 64 + i] = __expf(inc); GCG[(size_t)(n * 32 + hv) * 64 + i] = inc; }
    __syncthreads();
    { const int prod = wid >> 2, ti = wid & 3, g4 = lane >> 4, l15 = lane & 15; LAS bf16_t* As = prod ? QS : KS; LAS float* Out = prod ? QK : KK;
      bf16x8 af[4];
#pragma unroll
      for (int s = 0; s < 4; ++s) af[s] = *(LAS bf16x8*)(As + (16 * ti + l15) * QSTR + 32 * s + 8 * g4);
#pragma unroll
      for (int tj = 0; tj < 4; ++tj) { f32x4 acc = {0.f, 0.f, 0.f, 0.f};
#pragma unroll
          for (int s = 0; s < 4; ++s) { const bf16x8 bfg = *(LAS bf16x8*)(KS + (16 * tj + l15) * QSTR + 32 * s + 8 * g4); acc = __builtin_amdgcn_mfma_f32_16x16x32_bf16(af[s], bfg, acc, 0, 0, 0); }
#pragma unroll
          for (int r = 0; r < 4; ++r) Out[(16 * ti + 4 * g4 + r) * 64 + 16 * tj + l15] = acc[r]; } }
    __syncthreads();
    { const int i = tid >> 3, j0 = (tid & 7) * 8;
      const float gi0 = GC[i], gi1 = GC[64 + i], bi0 = BETA[i], bi1 = BETA[64 + i];
      float in0[8], in1[8];
#pragma unroll
      for (int jj = 0; jj < 8; ++jj) { const int j = j0 + jj; const float kk = KK[i * 64 + j], qk = QK[i * 64 + j];
          const float d0 = __expf(gi0 - GC[j]), d1 = __expf(gi1 - GC[64 + j]);
          T1[i * 64 + j] = (j < i) ? bi1 * kk * d1 : 0.f; KK[i * 64 + j] = (j < i) ? bi0 * kk * d0 : 0.f;
          in0[jj] = (j <= i) ? qk * d0 : 0.f; in1[jj] = (j <= i) ? qk * d1 : 0.f; }
      u32x4 p0, p1; p0.x = cvtpk(in0[0], in0[1]); p0.y = cvtpk(in0[2], in0[3]); p0.z = cvtpk(in0[4], in0[5]); p0.w = cvtpk(in0[6], in0[7]);
      p1.x = cvtpk(in1[0], in1[1]); p1.y = cvtpk(in1[2], in1[3]); p1.z = cvtpk(in1[4], in1[5]); p1.w = cvtpk(in1[6], in1[7]);
      { const int fo = (((i >> 4) * 2 + (j0 >> 5)) * 64 + (i & 15) + 16 * ((j0 & 31) >> 3)) * 8;
        *(u32x4*)(INTRA + (size_t)(n * 32 + 2 * hk) * 4096 + fo) = p0; *(u32x4*)(INTRA + (size_t)(n * 32 + 2 * hk + 1) * 4096 + fo) = p1; }
#pragma unroll
      for (int rep = 0; rep < 2; ++rep) { const int idx = tid + rep * 512, r = idx >> 4, c8 = (idx & 15) * 8; *(u32x4*)(QN + (size_t)(n * 16 + hk) * 8192 + (((r >> 4) * 4 + (c8 >> 5)) * 64 + (r & 15) + 16 * ((c8 & 31) >> 3)) * 8) = *(LAS u32x4*)(QS + r * QSTR + c8); }
      { const int d = tid & 127, cq = tid >> 7; unsigned wv[8];
#pragma unroll
        for (int c2 = 0; c2 < 8; ++c2) { const unsigned lo = KS[(16 * cq + 2 * c2) * QSTR + d], hi = KS[(16 * cq + 2 * c2 + 1) * QSTR + d]; wv[c2] = lo | (hi << 16); }
        bf16_t* dst = KT + (size_t)(n * 16 + hk) * 8192 + (((d >> 4) * 2 + (cq >> 1)) * 64 + (d & 15) + 32 * (cq & 1)) * 8;
        *(u32x4*)dst = (u32x4){wv[0], wv[1], wv[2], wv[3]}; *(u32x4*)(dst + 16 * 8) = (u32x4){wv[4], wv[5], wv[6], wv[7]}; } }
    __syncthreads();
    { const int j = tid >> 8, col = tid & 255, hv = 2 * hk + j; int toff = j ? OFF_T1 : OFF_KK; asm volatile("" : "+v"(toff)); const LAS float* T = (const LAS float*)(lds + toff);
      f32x2 xp[32];
      if (col < 128) {
#pragma unroll
          for (int i = 0; i < 64; ++i) xp[i >> 1][i & 1] = bf2f(VS[i * 256 + j * 128 + col]) * BETA[j * 64 + i];
      } else {
#pragma unroll
          for (int i = 0; i < 64; ++i) xp[i >> 1][i & 1] = bf2f(KS[i * QSTR + (col - 128)]) * BETA[j * 64 + i] * EGC[j * 64 + i];
      }
      { TRow8 r1; load_trow8<1>(r1, T); solve_rows<1>(xp, T, r1); }
      if (col < 128) { bf16_t* dst = UT + (size_t)(n * 32 + hv) * 8192 + (((col >> 4) * 4) * 64 + (col & 15)) * 4;
#pragma unroll
          for (int q4 = 0; q4 < 16; ++q4) { u32x2 p; p.x = cvtpk(xp[2 * q4][0], xp[2 * q4][1]); p.y = cvtpk(xp[2 * q4 + 1][0], xp[2 * q4 + 1][1]);
              *(u32x2*)(dst + ((q4 >> 2) * 64 + 16 * (q4 & 3)) * 4) = p; } }
      else { const int d = col - 128; bf16_t* dst = NWB + (size_t)(n * 32 + hv) * 8192 + ((d >> 5) * 64 + 16 * ((d & 31) >> 3)) * 8 + (d & 7);
#pragma unroll
          for (int i = 0; i < 64; ++i) { *dst = f2bf(-xp[i >> 1][i & 1]); dst += ((i & 15) == 15) ? (2048 - 15 * 8) : 8; asm volatile("" : "+v"(dst)); } } }
    __syncthreads();
}

constexpr int SSTR = 136, VSTR = 72;
constexpr int OFF_ST = 0, OFF_VN = OFF_ST + 16 * SSTR * 2, OFF_VSC = OFF_VN + 16 * VSTR * 2, LDS_SCAN = OFF_VSC + 16 * VSTR * 2;
__device__ __forceinline__ void scan_item(int hv, int cb, const bf16_t* __restrict__ QN, const bf16_t* __restrict__ KT, const bf16_t* __restrict__ UT, const bf16_t* __restrict__ NWB, const bf16_t* __restrict__ INTRA,
                                          const float* __restrict__ GCG, bf16_t* __restrict__ OG, LAS unsigned char* lds, int wv) {
    const int tid = tidw(wv), w = wv, lane = tid & 63, g4 = lane >> 4, l15 = lane & 15, wq = w & 3, hk = hv >> 1;
    LAS bf16_t* ST = (LAS bf16_t*)(lds + OFF_ST); LAS bf16_t* VN = (LAS bf16_t*)(lds + OFF_VN); LAS bf16_t* VSC = (LAS bf16_t*)(lds + OFF_VSC);
    for (int i = tid; i < 16 * SSTR / 2; i += NTHREADS) ((LAS unsigned*)ST)[i] = 0u;
    f32x4 Sacc = {0.f, 0.f, 0.f, 0.f};
    __syncthreads();
    struct Ops { bf16x8 a1[4]; bf16x8 ax[4]; u32x2 u; f32x4 gc; float gl; };
    const bf16_t* p1base = (w < 4) ? NWB + (size_t)hv * 8192 + (wq * 256 + lane) * 8 : QN + (size_t)hk * 8192 + (wq * 256 + lane) * 8;
    const size_t p1stride = (w < 4) ? (size_t)32 * 64 * 128 : (size_t)16 * 64 * 128;
    f32x4 Sacc1 = {0.f, 0.f, 0.f, 0.f};
    const bf16_t* pa1 = p1base;
    const bf16_t* pax = (w >= 4) ? INTRA + (size_t)hv * 4096 + (wq * 128 + lane) * 8 : KT + (size_t)hk * 8192 + (w * 128 + lane) * 8;
    const size_t axstride = (w >= 4) ? (size_t)32 * 64 * 64 : (size_t)16 * 128 * 64;
    const bf16_t* pu = UT + (size_t)hv * 8192 + ((cb * 4 + wq) * 64 + lane) * 4;
    const float* pgc = GCG + (size_t)hv * 64 + 16 * wq + 4 * g4;
    const float* pgl = GCG + (size_t)hv * 64 + 63;
    bf16_t* pog = OG + ((size_t)(hv * 8 + cb) * 64 + 16 * wq) * 16;
    LAS bf16_t* OT = (LAS bf16_t*)(lds + LDS_SCAN);
#define LOADOPS(O, n) do { \
      _Pragma("unroll") for (int s = 0; s < 4; ++s) O.a1[s] = *(const bf16x8*)(pa1 + 512 * s); \
      O.ax[0] = *(const bf16x8*)(pax); O.ax[1] = *(const bf16x8*)(pax + 512); \
      if (w < 4) { O.ax[2] = *(const bf16x8*)(pax + 4096); O.ax[3] = *(const bf16x8*)(pax + 4096 + 512); O.u = *(const u32x2*)(pu); } \
      O.gc = *(const f32x4*)(pgc); O.gl = *pgl; \
      pa1 += p1stride; pax += axstride; pu += 32 * 128 * 64; pgc += 32 * 64; pgl += 32 * 64; } while (0)
#define SCAN_STEP(O_, n) do { \
        f32x4 acc, acc2 = {0.f, 0.f, 0.f, 0.f}; \
        if (w < 4) acc = (f32x4){bflo(O_.u.x), bfhi(O_.u.x), bflo(O_.u.y), bfhi(O_.u.y)}; else acc = (f32x4){0.f, 0.f, 0.f, 0.f}; \
        { const bf16x8 b0 = *(LAS bf16x8*)(ST + l15 * SSTR + 8 * g4), b1 = *(LAS bf16x8*)(ST + l15 * SSTR + 32 + 8 * g4), b2 = *(LAS bf16x8*)(ST + l15 * SSTR + 64 + 8 * g4), b3 = *(LAS bf16x8*)(ST + l15 * SSTR + 96 + 8 * g4); \
          acc = __builtin_amdgcn_mfma_f32_16x16x32_bf16(O_.a1[0], b0, acc, 0, 0, 0); acc2 = __builtin_amdgcn_mfma_f32_16x16x32_bf16(O_.a1[2], b2, acc2, 0, 0, 0); \
          acc = __builtin_amdgcn_mfma_f32_16x16x32_bf16(O_.a1[1], b1, acc, 0, 0, 0); acc2 = __builtin_amdgcn_mfma_f32_16x16x32_bf16(O_.a1[3], b3, acc2, 0, 0, 0); acc = acc + acc2; } \
        if (w < 4) { u32x2 p; p.x = cvtpk(acc[0], acc[1]); p.y = cvtpk(acc[2], acc[3]); *(LAS u32x2*)(VN + l15 * VSTR + 16 * wq + 4 * g4) = p; \
            const float e0 = __expf(O_.gl - O_.gc[0]), e1 = __expf(O_.gl - O_.gc[1]), e2 = __expf(O_.gl - O_.gc[2]), e3 = __expf(O_.gl - O_.gc[3]); \
            p.x = cvtpk(acc[0] * e0, acc[1] * e1); p.y = cvtpk(acc[2] * e2, acc[3] * e3); *(LAS u32x2*)(VSC + l15 * VSTR + 16 * wq + 4 * g4) = p; } \
        else { acc[0] *= __expf(O_.gc[0]); acc[1] *= __expf(O_.gc[1]); acc[2] *= __expf(O_.gc[2]); acc[3] *= __expf(O_.gc[3]); } \
        __syncthreads(); \
        if (w >= 4) { \
            _Pragma("unroll") \
            for (int s = 0; s < 2; ++s) { const bf16x8 b = *(LAS bf16x8*)(VN + l15 * VSTR + 32 * s + 8 * g4); acc = __builtin_amdgcn_mfma_f32_16x16x32_bf16(O_.ax[s], b, acc, 0, 0, 0); } \
            { LAS bf16_t* ot = OT + (w - 4) * 256;        \
              _Pragma("unroll") \
              for (int r = 0; r < 4; ++r) ot[(4 * g4 + r) * 16 + l15] = f2bf(acc[r]); \
              asm volatile("s_waitcnt lgkmcnt(0)" ::: "memory"); \
              if (lane < 32) *(u32x4*)(pog + lane * 8) = *(LAS u32x4*)(ot + lane * 8); } } \
        else { const float eg = __expf(O_.gl); Sacc = Sacc * eg; Sacc1 = Sacc1 * eg; \
            const bf16x8 b0 = *(LAS bf16x8*)(VSC + l15 * VSTR + 8 * g4), b1 = *(LAS bf16x8*)(VSC + l15 * VSTR + 32 + 8 * g4); \
            Sacc = __builtin_amdgcn_mfma_f32_16x16x32_bf16(O_.ax[0], b0, Sacc, 0, 0, 0); Sacc1 = __builtin_amdgcn_mfma_f32_16x16x32_bf16(O_.ax[2], b0, Sacc1, 0, 0, 0); \
            Sacc = __builtin_amdgcn_mfma_f32_16x16x32_bf16(O_.ax[1], b1, Sacc, 0, 0, 0); Sacc1 = __builtin_amdgcn_mfma_f32_16x16x32_bf16(O_.ax[3], b1, Sacc1, 0, 0, 0); \
            u32x2 p; p.x = cvtpk(Sacc[0], Sacc[1]); p.y = cvtpk(Sacc[2], Sacc[3]); *(LAS u32x2*)(ST + l15 * SSTR + 16 * w + 4 * g4) = p; \
            p.x = cvtpk(Sacc1[0], Sacc1[1]); p.y = cvtpk(Sacc1[2], Sacc1[3]); *(LAS u32x2*)(ST + l15 * SSTR + 16 * (w + 4) + 4 * g4) = p; } \
        pog += 32 * 8 * 64 * 16; __syncthreads(); \
    } while (0)
    Ops ring[4];
    LOADOPS(ring[0], 0); LOADOPS(ring[1], 1); LOADOPS(ring[2], 2);
    for (int nb = 0; nb < 128; nb += 4) {
#pragma unroll
        for (int k = 0; k < 4; ++k) { const int n = nb + k; LOADOPS(ring[(k + 3) % 4], n + 3); SCAN_STEP(ring[k], n); }
    }
#undef SCAN_STEP
#undef LOADOPS
}
}

constexpr size_t MiB = 1u << 20;
constexpr size_t WS_WIN = 0, WS_WOUT = 50 * MiB, WS_WGU = 66 * MiB, WS_WD = 110 * MiB;
constexpr size_t WS_H = 132 * MiB, WS_XN = 196 * MiB, WS_PROJ = 228 * MiB, WS_Z = 356 * MiB, WS_MIX = 420 * MiB;
constexpr size_t WS_G1 = 484 * MiB, WS_G2 = 548 * MiB, WS_G3 = 612 * MiB, WS_G4 = 644 * MiB, WS_G5 = 676 * MiB, WS_SM = 708 * MiB, WS_XF = 716 * MiB, WS_END = 732 * MiB;
constexpr size_t WS_CTL = WS_SM + 4 * MiB;
constexpr size_t XSLAB = (size_t)M * 64;
constexpr int LDS_BYTES = 147456;

#ifndef EN_MIX
#define EN_MIX 7
#endif
#ifndef EN_FFN
#define EN_FFN 1
#endif
struct Args { const float* in[25]; float* out; unsigned char* ws; };

typedef __attribute__((address_space(4))) const unsigned char* kargp_t;
__device__ __forceinline__ const float* kin(int i) {
    kargp_t kp = (kargp_t)__builtin_amdgcn_kernarg_segment_ptr(); asm volatile("" : "+s"(kp));
    return (const float*)*(const __attribute__((address_space(1))) float* const __attribute__((address_space(4)))*)(kp + 8 * i);
}
__global__ void __launch_bounds__(NTHREADS) mega_fwd(Args args) {
    extern __shared__ __attribute__((aligned(16))) unsigned char lds[];
    cg::grid_group grid = cg::this_grid();
    LAS unsigned char* L = (LAS unsigned char*)lds;
#define G opq_i((int)gridDim.x)
#define bid opq_i((int)blockIdx.x)
    const int WV = __builtin_amdgcn_readfirstlane((int)threadIdx.x >> 6);
    { volatile LAS unsigned* st = (volatile LAS unsigned*)(L + LDS_BYTES - 16); if (threadIdx.x < 4) st[threadIdx.x] = 0u; __syncthreads();
      (void)xcd_barrier_post((unsigned*)(args.ws + WS_CTL), st); }
#define GSYNC() do { XcdBarrier b_; b_.bar = (unsigned*)WSP(WS_CTL); b_.x = xb_xcc_id(); b_.st = (volatile LAS unsigned*)(L + LDS_BYTES - 16); xcd_barrier(b_); } while (0)
    unsigned char* ws0 = args.ws;
#define PV const int tid = tidw(WV), lane = tid & 63, wave = WV; const int gw = bid * NWAVES + wave, ngw = G * NWAVES; LAS float* scr = (LAS float*)(L + wave * 16640); (void)lane; (void)gw; (void)ngw; (void)scr;
#define VCU ((G % 8 == 0) ? (bid % 8) * (G / 8) + bid / 8 : bid)
#define WSP(off) (ws0 + opq((size_t)(off)))
#define Win ((bf16_t*)WSP(WS_WIN))
#define Wout ((bf16_t*)WSP(WS_WOUT))
#define Wgu ((bf16_t*)WSP(WS_WGU))
#define Wd ((bf16_t*)WSP(WS_WD))
#define H ((bf16_t*)WSP(WS_H))
#define XN ((bf16_t*)WSP(WS_XN))
#define PROJ ((bf16_t*)WSP(WS_PROJ))
#define ZB ((bf16_t*)WSP(WS_Z))
#define MIX ((bf16_t*)WSP(WS_MIX))
#define OM0 ((float*)WSP(WS_G1))
#define OM1 ((float*)WSP(WS_G2))
#define UT ((bf16_t*)WSP(WS_G1))
#define NWB ((bf16_t*)WSP(WS_G2))
#define QN ((bf16_t*)WSP(WS_G3))
#define KT ((bf16_t*)WSP(WS_G4))
#define INTRA ((bf16_t*)WSP(WS_G5))
#define XF ((float*)WSP(WS_XF))
#define NCK ((float*)WSP(WS_SM + 2 * MiB))
#define GCG ((float*)WSP(WS_SM + 3 * MiB))

    if (args.out == nullptr) grid.sync();
#pragma unroll 1
    for (int layer = 0; layer < 4; ++layer) {
        const int kind = layer % 3, slot = layer / 3;
        { PV
            if (kind == 0) { cvt_matrix(kin(4) + (size_t)slot * 2048 * 6144, 6144, 0, 6144, 2048, Win, 0, 0, scr, gw, ngw, lane);
                             cvt_matrix(kin(5) + (size_t)slot * 2048 * 2048, 2048, 0, 2048, 2048, Wout, 0, 0, scr, gw, ngw, lane); }
            else if (kind == 1) { cvt_matrix(kin(11), 8208, 0, 8208, 2048, Win, 0, 0, scr, gw, ngw, lane);
                                  cvt_matrix(kin(12), 2048, 0, 2048, 2048, Wout, 0, 0, scr, gw, ngw, lane); }
            else { cvt_matrix(kin(16), 12352, 0, 12352, 2048, Win, 0, 0, scr, gw, ngw, lane);
                   cvt_matrix(kin(17), 2048, 0, 2048, 4096, Wout, 0, 0, scr, gw, ngw, lane); }
            cvt_matrix(kin(22) + (size_t)layer * 2048 * FF, FF, 0, FF, 2048, Wgu, 1, 0, scr, gw, ngw, lane);
            cvt_matrix(kin(23) + (size_t)layer * 2048 * FF, FF, 0, FF, 2048, Wgu, 2, 0, scr, gw, ngw, lane);
            cvt_matrix(kin(24) + (size_t)layer * FF * 2048, 2048, 0, 2048, FF, Wd, 0, 0, scr, gw, ngw, lane);
            if (layer == 0) norm_rows<false>(kin(0), kin(1), XN, nullptr, gw, ngw, lane);
            else norm_rows_b<false>(H, kin(1) + layer * DM, XN, nullptr, gw, ngw, lane);
        }
        GSYNC();
        if ((EN_MIX >> kind) & 1) {
        {
            const int N = kind == 0 ? 6144 : kind == 1 ? 8192 : 12288;
            pg8::Gemm g{XN, Win, M, N, DM, DM / 64}; pg8::StaticOrder S; S.init(M, N, G, bid);
            pg8::EpiStore E;
            if (kind == 0) E = pg8::EpiStore{PROJ, 6144, PROJ, 6144, 1 << 30, XF, 16, 1 << 30, 2048, QSCALE};
            else if (kind == 1) E = pg8::EpiStore{PROJ, 8192, PROJ, 8192, 1 << 30, XF, 16, 8192, 0, 1.f};
            else E = pg8::EpiStore{PROJ, 8192, ZB, 4096, 8192, XF, 64, 12288, 0, 1.f};
            pg8::gemm_phase<pg8::EpiStore, pg8::StaticOrder, true, true>(L, g, S, E, WV);
            if (kind != 0) {
                pg8::Gemm g2{XN, Win, M, N + 256, DM, 4}; pg8::SplitKOrder S2; S2.init(M, 8, N / 256, G, bid);
                pg8::EpiXF E2{XF, kind == 1 ? 16 : 64, XSLAB, kind == 1 ? 1 : 0};
                pg8::gemm_phase<pg8::EpiXF, pg8::SplitKOrder, true, true>(L, g2, S2, E2, WV);
            }
        }
        GSYNC();
        if (kind == 0) { {
            for (int idx = VCU; idx < 1024; idx += G) { const int v = idx & 255, i = idx >> 8, vh = v >> 3, s = v & 7; const int qb = i == 0 ? s : i == 1 ? 15 - s : i == 2 ? 16 + s : 31 - s;
                const int mp = vh >> 4, hd = (vh >> 1) & 7, vhalf = vh & 1;
                const bf16_t* Qb = PROJ + (size_t)(256 * qb) * 6144 + mp * 1024 + hd * 128; const bf16_t* Kh = PROJ + 2048 + mp * 1024 + hd * 128; const bf16_t* Vh = PROJ + 4096 + hd * 256 + vhalf * 128;
                float* Of = (mp ? OM1 : OM0) + (size_t)(256 * qb) * 2048 + hd * 256 + vhalf * 128;
                att::attn_unit<0, 6144, 2>(Qb, Kh, Vh, qb, nullptr, Of, nullptr, nullptr, (char*)lds, WV); } }
            GSYNC();
            PV
            diff_combine(OM0, OM1, kin(6) + slot * 128, kin(7) + slot * 128, kin(8) + slot * 128, kin(9) + slot * 128, kin(10) + slot * 256,
                         0.8f - 0.6f * expf(-0.3f * (float)layer), MIX, gw, ngw, lane);
        } else if (kind == 1) { { PV
            fox_qknorm(PROJ, kin(14), kin(15), gw, ngw, lane);
            for (int hd = bid; hd < 16; hd += G) fox_cumsum(XF, kin(13), NCK, hd, (LAS float*)L, tid); }
            GSYNC();
            for (int idx = VCU; idx < 512; idx += G) { const int v = idx & 255, i = idx >> 8, hd = v >> 4, s = v & 15; const int qb = i == 0 ? s : 31 - s;
                const bf16_t* Qb = PROJ + (size_t)(256 * qb) * 8192 + hd * 128; const bf16_t* Kh = PROJ + 2048 + hd * 128; const bf16_t* Vh = PROJ + 4096 + hd * 128;
                att::attn_unit<1, 8192, 1>(Qb, Kh, Vh, qb, NCK + (size_t)hd * M, nullptr, MIX + (size_t)(256 * qb) * 2048 + hd * 128, PROJ + (size_t)(256 * qb) * 8192 + 6144 + hd * 128, (char*)lds, WV); }
        } else {
            for (int u = bid; u < 2048; u += G) gdn::prep_unit(u & 15, u >> 4, PROJ, XF, kin(18), kin(19), kin(20), QN, KT, UT, NWB, INTRA, GCG, L, WV);
            GSYNC();
            for (int wi = bid; wi < 256; wi += G) gdn::scan_item(wi & 31, wi >> 5, QN, KT, UT, NWB, INTRA, GCG, PROJ  , L, WV);
            GSYNC();
            PV
            gdn_post(PROJ, ZB, kin(21), MIX, gw, ngw, lane);
        }
        GSYNC();
        {
            const int K = kind == 2 ? 4096 : 2048;
            pg8::Gemm g{MIX, Wout, M, DM, K, K / 64}; pg8::StaticOrder S; S.init(M, DM, G, bid);
            pg8::EpiRes E{layer == 0 ? kin(0) : (const float*)nullptr, H, H, DM};
            pg8::gemm_phase<pg8::EpiRes, pg8::StaticOrder, true, true>(L, g, S, E, WV);
        }
        GSYNC();
        }
        if (EN_FFN) {
        { PV norm_rows_b<false>(H, kin(2) + layer * DM, XN, nullptr, gw, ngw, lane); }
        GSYNC();
        {
            pg8::Gemm g{XN, Wgu, M, 2 * FF, DM, DM / 64}; pg8::StaticOrder S; S.init(M, 2 * FF, G, bid);
            pg8::EpiSwiglu E{PROJ, FF};
            pg8::gemm_phase<pg8::EpiSwiglu, pg8::StaticOrder, true, true>(L, g, S, E, WV);
        }
        GSYNC();
        {
            pg8::Gemm g{PROJ, Wd, M, DM, FF, FF / 64}; pg8::StaticOrder S; S.init(M, DM, G, bid);
            pg8::EpiRes E{nullptr, H, H, DM};
            pg8::gemm_phase<pg8::EpiRes, pg8::StaticOrder, true, true>(L, g, S, E, WV);
        }
        GSYNC();
        }
    }
    { PV norm_rows_b<true, 2>(H, kin(3), nullptr, args.out, gw, ngw, lane); }
}

extern "C" void kernel_launch(void* const* d_in, const int* in_sizes, int n_in, void* d_out, int out_size, void* d_ws, size_t ws_size, hipStream_t stream) {
    static int grid_blocks = 0;
    if (grid_blocks == 0) {
        if (n_in != 25 || out_size != M * DM || ws_size < WS_END) { fprintf(stderr, "kernel_launch: unexpected shapes (n_in %d, out %d, ws %zu)\n", n_in, out_size, ws_size); grid_blocks = -1; return; }
        int dev = 0, cus = 0, per_cu = 0;
        hipGetDevice(&dev); hipDeviceGetAttribute(&cus, hipDeviceAttributeMultiprocessorCount, dev);
        hipFuncSetAttribute((const void*)mega_fwd, hipFuncAttributeMaxDynamicSharedMemorySize, LDS_BYTES);
        hipOccupancyMaxActiveBlocksPerMultiprocessor(&per_cu, (const void*)mega_fwd, NTHREADS, LDS_BYTES);
        if (per_cu < 1) per_cu = 1;
        grid_blocks = cus * 1;
        (void)hipGetLastError();
    }
    if (grid_blocks < 0) return;
    if (hipMemsetAsync((char*)d_ws + WS_CTL, 0, 16384, stream) != hipSuccess) { fprintf(stderr, "kernel_launch: memset failed\n"); return; }
    Args a{};
    for (int i = 0; i < 25; ++i) a.in[i] = (const float*)d_in[i];
    a.out = (float*)d_out; a.ws = (unsigned char*)d_ws;
    void* kargs[] = {&a};
    hipError_t e = hipLaunchCooperativeKernel((const void*)mega_fwd, dim3(grid_blocks), dim3(NTHREADS), kargs, LDS_BYTES, stream);
    if (e != hipSuccess) fprintf(stderr, "cooperative launch failed: %s (grid %d)\n", hipGetErrorString(e), grid_blocks);
}
```

```cpp
#include <hip/hip_runtime.h>
#include <hip/hip_cooperative_groups.h>
#include <cstdio>
#include <cstdint>
#include <cmath>
namespace cg = cooperative_groups;
__device__ __forceinline__ int lane_asm() { int l; asm volatile("v_mbcnt_lo_u32_b32 %0, -1, 0\n\tv_mbcnt_hi_u32_b32 %0, -1, %0" : "=v"(l)); return l; }
__device__ __forceinline__ int tidw(int wv) { return wv * 64 + lane_asm(); }
__device__ __forceinline__ size_t opq(size_t v) { asm volatile("" : "+s"(v)); return v; }
__device__ __forceinline__ float shx(float v, int o) { return __builtin_bit_cast(float, __builtin_amdgcn_ds_bpermute((lane_asm() ^ o) << 2, __builtin_bit_cast(int, v))); }
__device__ __forceinline__ float shup(float v, int o) { const int l = lane_asm(); return __builtin_bit_cast(float, __builtin_amdgcn_ds_bpermute((l >= o ? l - o : l) << 2, __builtin_bit_cast(int, v))); }
__device__ __forceinline__ int opq_i(int v) { asm volatile("" : "+s"(v)); return v; }
namespace pg8 {
#define PG8_LAS __attribute__((address_space(3)))
typedef unsigned short bf16_t;
typedef short bf16x8 __attribute__((ext_vector_type(8)));
typedef float f32x4 __attribute__((ext_vector_type(4)));
typedef unsigned u32x4 __attribute__((ext_vector_type(4)));
constexpr int BM = 256, BK = 64, HALF = 128, HTB = HALF * BK * 2  , STAGE_BYTES = 8 * HTB, NXCD = 8, WGM = 8;

__host__ __device__ __forceinline__ int lds_byte(int r, int c) { const int st = (r >> 4) * 2 + (c >> 5), rr = r & 15, cc = c & 31, ob = rr * 64 + cc * 2; return st * 1024 + (ob ^ (((ob >> 9) & 1) << 5)); }
__host__ __device__ __forceinline__ void stage_rc(int b, int& R, int& C) { const int st = b / 1024, sb = b % 1024, swz = sb ^ (((sb >> 9) & 1) << 5); R = (st >> 1) * 16 + swz / 64; C = (st & 1) * 32 + (swz % 64) / 2; }
__host__ __device__ __forceinline__ int perm32(int rho) { const int n = rho >> 4, i = rho & 15; return 8 * (i >> 2) + 4 * n + (i & 3); }

struct Unit { int pm, pn, ks, ui; };
struct Gemm { const bf16_t* A; const bf16_t* Bt; int M, N, K; int kt; };

struct StaticOrder {
    int nM, nN, nwg, G, c;
    __host__ __device__ void init(int M, int N, int G_, int c_) { nM = M / BM; nN = N / BM; nwg = nM * nN; G = G_; c = c_; }
    __host__ __device__ bool next(int i, Unit& u) const {
        const long L = (long)i * G + c; if (L >= nwg) return false;
        int wgid = (int)L; { const int q = nwg / NXCD, r = nwg % NXCD, xcd = wgid % NXCD, off = wgid / NXCD; wgid = (xcd < r ? xcd * (q + 1) : r * (q + 1) + (xcd - r) * q) + off; }
        const int nig = WGM * nN, gid = wgid / nig, fm = gid * WGM, gsz = (nM - fm) < WGM ? (nM - fm) : WGM;
        u.pm = fm + ((wgid % nig) % gsz); u.pn = (wgid % nig) / gsz; u.ks = 0; u.ui = i; return true;
    }
    __device__ __forceinline__ void a_ready(const Unit&) const {}
    __device__ __forceinline__ void done(const Unit&) const {}
};
struct SplitKOrder {
    int nunits, G, c, SK, pn;
    __host__ __device__ void init(int M, int SK_, int pn_, int G_, int c_) { nunits = (M / BM) * SK_; G = G_; c = c_; SK = SK_; pn = pn_; }
    __host__ __device__ bool next(int i, Unit& u) const { const int L = i * G + c; if (L >= nunits) return false; u.pm = L / SK; u.ks = L % SK; u.pn = pn; u.ui = i; return true; }
    __device__ __forceinline__ void a_ready(const Unit&) const {}
    __device__ __forceinline__ void done(const Unit&) const {}
};


__device__ __forceinline__ unsigned cvt_pk_bf16(float lo, float hi) { unsigned r; asm volatile("v_cvt_pk_bf16_f32 %0, %1, %2" : "=v"(r) : "v"(lo), "v"(hi)); return r; }
typedef unsigned u32x2v __attribute__((ext_vector_type(2)));
typedef __bf16 bf16x2v_t __attribute__((ext_vector_type(2))); typedef float f32x2v_t __attribute__((ext_vector_type(2)));
__device__ __forceinline__ unsigned cvtpk2(float lo, float hi) { f32x2v_t v = {lo, hi}; bf16x2v_t b = __builtin_convertvector(v, bf16x2v_t); return __builtin_bit_cast(unsigned, b); }
constexpr int RT_OFF = 131072;
template <class Sched> __device__ __forceinline__ void build_rinv_table(PG8_LAS unsigned char* lds, const Sched& S, const float* RSS, int tid) {
    PG8_LAS float* RT = (PG8_LAS float*)(lds + RT_OFF); Unit u;
    for (int i = 0; i < 12 && S.next(i, u); ++i) { if (tid < 256) { const float* p = RSS + ((size_t)u.pm * BM + tid) * 32; float s = 0.f;
#pragma unroll
            for (int j = 0; j < 8; ++j) { const f32x4 a = *(const f32x4*)(p + 4 * j); s += (a[0] + a[1]) + (a[2] + a[3]); }
            RT[i * 256 + tid] = rsqrtf(s * (1.f / 2048.f) + 1e-6f); } }
    __syncthreads();
}
__device__ __forceinline__ float row_rinv(const PG8_LAS float* RT, const Unit& u, int rl) { return RT[u.ui * 256 + rl]; }
struct EpiStore {
    static constexpr bool PERM = true, AFTER_DRAIN = false;
    bf16_t* O0; int ld0; bf16_t* O1; int ld1; int split;
    float* XF; int ldx; int xsplit;
    int qcols; float qscale;
    const PG8_LAS float* RT;
    __device__ __forceinline__ void operator()(const f32x4 (&acc)[2][2][4][2], const Unit& u, int wr, int wc, int fr, int fq) const {
        const int row0 = u.pm * BM + wr * 64 + fr; int colt = u.pn * BM;
        if (colt >= xsplit) {
#pragma unroll
            for (int ai = 0; ai < 2; ++ai)
#pragma unroll
                for (int m = 0; m < 4; ++m) { const size_t row = (size_t)(row0 + ai * HALF + m * 16);
#pragma unroll
                    for (int n = 0; n < 2; ++n) { const int c = wc * 32 + 8 * fq + 4 * n; if (c < ldx) *(f32x4*)(XF + row * ldx + c) = acc[ai][0][m][n]; } }
            return;
        }
        const float sc = (colt < qcols) ? qscale : 1.f;
        bf16_t* base = O0; int ld = ld0; if (colt >= split) { base = O1; ld = ld1; colt -= split; }
        const int col0 = colt + wc * 32 + 8 * fq;
#pragma unroll
        for (int ai = 0; ai < 2; ++ai)
#pragma unroll
            for (int m = 0; m < 4; ++m) { bf16_t* rowp = base + (size_t)(row0 + ai * HALF + m * 16) * ld + col0;
                const float rs = sc * row_rinv(RT, u, wr * 64 + fr + ai * HALF + m * 16);
#pragma unroll
                for (int bj = 0; bj < 2; ++bj) { const f32x4 v0 = acc[ai][bj][m][0] * rs, v1 = acc[ai][bj][m][1] * rs;
                    u32x4 w; w.x = cvt_pk_bf16(v0[0], v0[1]); w.y = cvt_pk_bf16(v0[2], v0[3]); w.z = cvt_pk_bf16(v1[0], v1[1]); w.w = cvt_pk_bf16(v1[2], v1[3]);
                    *(u32x4*)(rowp + bj * HALF) = w; } }
    }
};
__device__ __forceinline__ float silu_f(float x) { return x * __builtin_amdgcn_rcpf(1.f + __expf(-x)); }
struct EpiSwiglu {
    static constexpr bool PERM = true, AFTER_DRAIN = false;
    bf16_t* O; int ld; const PG8_LAS float* RT;
    __device__ __forceinline__ void operator()(const f32x4 (&acc)[2][2][4][2], const Unit& u, int wr, int wc, int fr, int fq) const {
        const int row0 = u.pm * BM + wr * 64 + fr; const int col0 = u.pn * HALF + wc * 32 + 8 * fq;
#pragma unroll
        for (int ai = 0; ai < 2; ++ai)
#pragma unroll
            for (int m = 0; m < 4; ++m) { bf16_t* rowp = O + (size_t)(row0 + ai * HALF + m * 16) * ld + col0;
                const float rs = row_rinv(RT, u, wr * 64 + fr + ai * HALF + m * 16);
                const f32x4 g0 = acc[ai][0][m][0] * rs, g1 = acc[ai][0][m][1] * rs, u0 = acc[ai][1][m][0] * rs, u1 = acc[ai][1][m][1] * rs;
                u32x4 w; w.x = cvt_pk_bf16(silu_f(g0[0]) * u0[0], silu_f(g0[1]) * u0[1]); w.y = cvt_pk_bf16(silu_f(g0[2]) * u0[2], silu_f(g0[3]) * u0[3]);
                w.z = cvt_pk_bf16(silu_f(g1[0]) * u1[0], silu_f(g1[1]) * u1[1]); w.w = cvt_pk_bf16(silu_f(g1[2]) * u1[2], silu_f(g1[3]) * u1[3]);
                *(u32x4*)rowp = w; }
    }
};
struct EpiRes {
    static constexpr bool PERM = true, AFTER_DRAIN = false;
    const float* basef; const bf16_t* baseb; bf16_t* out; int ld; float* RSSo;
    __device__ __forceinline__ void operator()(const f32x4 (&acc)[2][2][4][2], const Unit& u, int wr, int wc, int fr, int fq) const {
        const int row0 = u.pm * BM + wr * 64 + fr; const int col0 = u.pn * BM + wc * 32 + 8 * fq;
#pragma unroll
        for (int ai = 0; ai < 2; ++ai)
#pragma unroll
            for (int m = 0; m < 4; ++m) { const size_t off = (size_t)(row0 + ai * HALF + m * 16) * ld + col0; float ss = 0.f;
#pragma unroll
                for (int bj = 0; bj < 2; ++bj) { f32x4 b0, b1;
                    if (basef) { b0 = *(const f32x4*)(basef + off + bj * HALF); b1 = *(const f32x4*)(basef + off + bj * HALF + 4); }
                    else { const u32x4 w = *(const u32x4*)(baseb + off + bj * HALF);
                        b0 = (f32x4){__uint_as_float(w.x << 16), __uint_as_float(w.x & 0xffff0000u), __uint_as_float(w.y << 16), __uint_as_float(w.y & 0xffff0000u)};
                        b1 = (f32x4){__uint_as_float(w.z << 16), __uint_as_float(w.z & 0xffff0000u), __uint_as_float(w.w << 16), __uint_as_float(w.w & 0xffff0000u)}; }
                    const f32x4 o0 = b0 + acc[ai][bj][m][0], o1 = b1 + acc[ai][bj][m][1];
                    u32x4 p; p.x = cvtpk2(o0[0], o0[1]); p.y = cvtpk2(o0[2], o0[3]); p.z = cvtpk2(o1[0], o1[1]); p.w = cvtpk2(o1[2], o1[3]);
                    *(u32x4*)(out + off + bj * HALF) = p;
                    ss += ((o0[0] * o0[0] + o0[1] * o0[1]) + (o0[2] * o0[2] + o0[3] * o0[3])) + ((o1[0] * o1[0] + o1[1] * o1[1]) + (o1[2] * o1[2] + o1[3] * o1[3])); }
                ss += shx(ss, 16); ss += shx(ss, 32);
                if (fq == 0) RSSo[(size_t)(row0 + ai * HALF + m * 16) * 32 + 4 * u.pn + wc] = ss;
                if (m & 1) asm volatile("" ::: "memory"); }
    }
};

struct EpiXF {
    static constexpr bool PERM = true, AFTER_DRAIN = false;
    float* XF; int ldx; size_t slab; int tr; const PG8_LAS float* RT;
    __device__ __forceinline__ void operator()(const f32x4 (&acc)[2][2][4][2], const Unit& u, int wr, int wc, int fr, int fq) const {
        const int row0 = u.pm * BM + wr * 64 + fr; float* base = XF + (size_t)u.ks * slab;
#pragma unroll
        for (int ai = 0; ai < 2; ++ai)
#pragma unroll
            for (int m = 0; m < 4; ++m) { const size_t row = (size_t)(row0 + ai * HALF + m * 16); const float rs = row_rinv(RT, u, wr * 64 + fr + ai * HALF + m * 16);
#pragma unroll
                for (int n = 0; n < 2; ++n) { const int c = wc * 32 + 8 * fq + 4 * n;
                    if (c < ldx) { if (tr) {
#pragma unroll
                            for (int q = 0; q < 4; ++q) base[(size_t)(c + q) * 8192 + row] = acc[ai][0][m][n][q] * rs; }
                        else *(f32x4*)(base + row * ldx + c) = acc[ai][0][m][n] * rs; } } }
    }
};
template <class Epi, class Sched, bool ALIGN_EPI = false, bool SP2 = false>
__device__ __forceinline__ void gemm_phase(PG8_LAS unsigned char* lds, const Gemm g, const Sched& S, const Epi& E, int wv) {
    const int tid = tidw(wv), wid = wv, lane = tid & 63, wr = wid >> 2, wc = wid & 3, fr = lane & 15, fq = lane >> 4;
    const int K = g.K, nt = g.kt; const size_t ksl = (size_t)g.kt * BK * 2;
    unsigned voffA[2], voffB[2];
#pragma unroll
    for (int i = 0; i < 2; ++i) { int R, C; stage_rc(tid * 16 + i * 8192, R, C); const int Rb = Epi::PERM ? ((R & ~31) + perm32(R & 31)) : R;
        voffA[i] = (unsigned)(R * K + C) * 2u; voffB[i] = (unsigned)(Rb * K + C) * 2u; }
    const size_t kstep = (size_t)(BK * 2);
    const size_t hstep = (size_t)HALF * K * 2;
    const size_t tstep = 2 * hstep;
    const unsigned ldsw = (unsigned)wid * 1024u;
    const int aoff = lds_byte(wr * 64 + fr, fq * 8), boff = lds_byte(wc * 32 + fr, fq * 8);
#define PG8_SA(b, h) (((b) * 2 + (h)) * HTB)
#define PG8_SB(b, h) ((4 + (b) * 2 + (h)) * HTB)
#define PG8_STAGE(bufoff, gbase, voff) do { _Pragma("unroll") for (int _i = 0; _i < 2; ++_i) \
        __builtin_amdgcn_global_load_lds((const unsigned*)((const char*)(gbase) + (voff)[_i]), (PG8_LAS unsigned*)(lds + (bufoff) + ldsw + _i * 8192), 16, 0, 0); } while (0)
#define PG8_LDA(dst, b, h) do { _Pragma("unroll") for (int m = 0; m < 4; ++m) _Pragma("unroll") for (int k = 0; k < 2; ++k) dst[m][k] = *(const PG8_LAS bf16x8*)(lds + PG8_SA(b, h) + aoff + m * 2048 + k * 1024); } while (0)
#define PG8_LDB(dst, b, h) do { _Pragma("unroll") for (int n = 0; n < 2; ++n) _Pragma("unroll") for (int k = 0; k < 2; ++k) dst[n][k] = *(const PG8_LAS bf16x8*)(lds + PG8_SB(b, h) + boff + n * 2048 + k * 1024); } while (0)
#define PG8_MMA(ai, bj, At, Bt) do { __builtin_amdgcn_s_setprio(1); _Pragma("unroll") for (int m = 0; m < 4; ++m) _Pragma("unroll") for (int n = 0; n < 2; ++n) _Pragma("unroll") for (int k = 0; k < 2; ++k) \
        acc[ai][bj][m][n] = __builtin_amdgcn_mfma_f32_16x16x32_bf16(Bt[n][k], At[m][k], acc[ai][bj][m][n], 0, 0, 0); __builtin_amdgcn_s_setprio(0); } while (0)
#define PG8_WAIT_V(n) asm volatile("s_waitcnt vmcnt(" #n ")" ::: "memory")
#define PG8_WAIT_L(n) asm volatile("s_waitcnt lgkmcnt(" #n ")" ::: "memory")
#define PG8_BAR __builtin_amdgcn_s_barrier()
#define PG8_SCHED __builtin_amdgcn_sched_barrier(0)
    Unit cur, nxt; int ui = 0;
    if (!S.next(0, cur)) return;
    f32x4 acc[2][2][4][2];
#pragma unroll
    for (int a = 0; a < 2; ++a)
#pragma unroll
        for (int b = 0; b < 2; ++b)
#pragma unroll
            for (int m = 0; m < 4; ++m)
#pragma unroll
                for (int n = 0; n < 2; ++n) acc[a][b][m][n] = (f32x4){0.f, 0.f, 0.f, 0.f};
    bf16x8 At[4][2], B0[2][2], B1[2][2];
    const char* cA = (const char*)g.A + (size_t)cur.pm * tstep + (size_t)cur.ks * ksl; const char* cB = (const char*)g.Bt + (size_t)cur.pn * tstep + (size_t)cur.ks * ksl;
    S.a_ready(cur);
    if constexpr (SP2) {
        PG8_STAGE(PG8_SB(0, 0), cB, voffB); PG8_STAGE(PG8_SB(0, 1), cB + hstep, voffB); PG8_STAGE(PG8_SA(0, 0), cA, voffA); PG8_STAGE(PG8_SA(0, 1), cA + hstep, voffA);
        if (wr == 1) PG8_BAR;
        PG8_WAIT_V(2); PG8_BAR;
        PG8_STAGE(PG8_SB(1, 0), cB + kstep, voffB); PG8_STAGE(PG8_SA(1, 0), cA + kstep, voffA); PG8_STAGE(PG8_SB(1, 1), cB + hstep + kstep, voffB);
        PG8_WAIT_V(6); PG8_BAR;
    } else {
        PG8_STAGE(PG8_SB(0, 0), cB, voffB); PG8_STAGE(PG8_SA(0, 0), cA, voffA); PG8_STAGE(PG8_SB(0, 1), cB + hstep, voffB); PG8_STAGE(PG8_SA(0, 1), cA + hstep, voffA);
        if (wr == 1) PG8_BAR;
        PG8_WAIT_V(4); PG8_BAR;
        PG8_STAGE(PG8_SB(1, 0), cB + kstep, voffB); PG8_STAGE(PG8_SA(1, 0), cA + kstep, voffA); PG8_STAGE(PG8_SB(1, 1), cB + hstep + kstep, voffB);
        PG8_WAIT_V(6); PG8_BAR;
    }
    for (;;) {
        const bool has_next = S.next(ui + 1, nxt);
        const char* nA = has_next ? (const char*)g.A + (size_t)nxt.pm * tstep + (size_t)nxt.ks * ksl : cA; const char* nB = has_next ? (const char*)g.Bt + (size_t)nxt.pn * tstep + (size_t)nxt.ks * ksl : cB;
        for (int t = 0; t < nt; t += 2) {
            const bool last = (t == nt - 2);
            const char* a1 = cA + (size_t)(t + 1) * kstep;
            const char* a2 = last ? nA : cA + (size_t)(t + 2) * kstep; const char* b2 = last ? nB : cB + (size_t)(t + 2) * kstep;
            const char* a3 = a2 + kstep; const char* b3 = b2 + kstep;
            if (last && has_next) S.a_ready(nxt);
            if constexpr (SP2) {
            PG8_LDB(B0, 0, 0); PG8_LDB(B1, 0, 1); PG8_SCHED; PG8_LDA(At, 0, 0); PG8_STAGE(PG8_SA(1, 1), a1 + hstep, voffA);
            PG8_WAIT_V(8); PG8_WAIT_L(0); PG8_BAR; PG8_MMA(0, 0, At, B0); PG8_MMA(0, 1, At, B1); PG8_BAR; PG8_SCHED;
            PG8_LDA(At, 0, 1); PG8_STAGE(PG8_SB(0, 0), b2, voffB); PG8_STAGE(PG8_SB(0, 1), b2 + hstep, voffB); PG8_STAGE(PG8_SA(0, 0), a2, voffA);
            PG8_WAIT_V(8); PG8_WAIT_L(0); PG8_BAR; PG8_MMA(1, 0, At, B0); PG8_MMA(1, 1, At, B1); PG8_BAR; PG8_SCHED;
            PG8_LDB(B0, 1, 0); PG8_LDB(B1, 1, 1); PG8_SCHED; PG8_LDA(At, 1, 0); PG8_STAGE(PG8_SA(0, 1), a2 + hstep, voffA);
            PG8_WAIT_V(8); PG8_WAIT_L(0); PG8_BAR; PG8_MMA(0, 0, At, B0); PG8_MMA(0, 1, At, B1); PG8_BAR; PG8_SCHED;
            PG8_LDA(At, 1, 1); PG8_STAGE(PG8_SB(1, 0), b3, voffB); PG8_STAGE(PG8_SB(1, 1), b3 + hstep, voffB); PG8_STAGE(PG8_SA(1, 0), a3, voffA);
            PG8_WAIT_V(8); PG8_WAIT_L(0); PG8_BAR; PG8_MMA(1, 0, At, B0); PG8_MMA(1, 1, At, B1); PG8_BAR; PG8_SCHED;
            } else {
            PG8_LDB(B0, 0, 0); PG8_SCHED; PG8_LDA(At, 0, 0); PG8_STAGE(PG8_SA(1, 1), a1 + hstep, voffA);
            PG8_WAIT_L(8); PG8_BAR; PG8_WAIT_L(0); PG8_MMA(0, 0, At, B0); PG8_BAR; PG8_SCHED;
            PG8_LDB(B1, 0, 1); PG8_STAGE(PG8_SB(0, 0), b2, voffB);
            PG8_BAR; PG8_WAIT_L(0); PG8_MMA(0, 1, At, B1); PG8_BAR;
            PG8_LDA(At, 0, 1); PG8_STAGE(PG8_SA(0, 0), a2, voffA);
            PG8_BAR; PG8_WAIT_L(0); PG8_MMA(1, 0, At, B0); PG8_BAR; PG8_SCHED;
            PG8_STAGE(PG8_SB(0, 1), b2 + hstep, voffB);
            PG8_WAIT_V(6); PG8_BAR; PG8_MMA(1, 1, At, B1); PG8_BAR;
            PG8_LDB(B0, 1, 0); PG8_SCHED; PG8_LDA(At, 1, 0); PG8_STAGE(PG8_SA(0, 1), a2 + hstep, voffA);
            PG8_WAIT_L(8); PG8_BAR; PG8_WAIT_L(0); PG8_MMA(0, 0, At, B0); PG8_BAR; PG8_SCHED;
            PG8_LDB(B1, 1, 1); PG8_STAGE(PG8_SB(1, 0), b3, voffB);
            PG8_BAR; PG8_WAIT_L(0); PG8_MMA(0, 1, At, B1); PG8_BAR;
            PG8_LDA(At, 1, 1); PG8_STAGE(PG8_SA(1, 0), a3, voffA);
            PG8_BAR; PG8_WAIT_L(0); PG8_MMA(1, 0, At, B0); PG8_BAR; PG8_SCHED;
            PG8_STAGE(PG8_SB(1, 1), b3 + hstep, voffB);
            PG8_WAIT_V(6); PG8_BAR; PG8_MMA(1, 1, At, B1); PG8_BAR;
            }
        }
        if constexpr (ALIGN_EPI) { if (wr == 0) PG8_BAR; }
        if constexpr (!Epi::AFTER_DRAIN) { E(acc, cur, wr, wc, fr, fq); S.done(cur); }
        if (!has_next) break;
#pragma unroll
        for (int a = 0; a < 2; ++a)
#pragma unroll
            for (int b = 0; b < 2; ++b)
#pragma unroll
                for (int m = 0; m < 4; ++m)
#pragma unroll
                    for (int n = 0; n < 2; ++n) acc[a][b][m][n] = (f32x4){0.f, 0.f, 0.f, 0.f};
        cur = nxt; cA = nA; cB = nB; ++ui;
        if constexpr (ALIGN_EPI) { if (wr == 1) PG8_BAR; }
    }
    PG8_WAIT_V(0);
    if constexpr (!ALIGN_EPI) { if (wr == 0) PG8_BAR; }
    PG8_BAR;
    if constexpr (Epi::AFTER_DRAIN) { E.fused(acc, cur, wr, wc, fr, fq, lds, wid, lane); S.done(cur); }
#undef PG8_SA
#undef PG8_SB
#undef PG8_STAGE
#undef PG8_LDA
#undef PG8_LDB
#undef PG8_MMA
#undef PG8_WAIT_V
#undef PG8_WAIT_L
#undef PG8_BAR
#undef PG8_SCHED
}
}

#define LAS __attribute__((address_space(3)))
typedef unsigned short bf16_t;
typedef short bf16x8 __attribute__((ext_vector_type(8)));
typedef short s16x4 __attribute__((ext_vector_type(4)));
typedef float f32x4 __attribute__((ext_vector_type(4)));
typedef float f32x2 __attribute__((ext_vector_type(2)));
typedef float f32x16 __attribute__((ext_vector_type(16)));
typedef unsigned u32x4 __attribute__((ext_vector_type(4)));
typedef unsigned u32x2 __attribute__((ext_vector_type(2)));

constexpr int M = 8192, DM = 2048, FF = 5632;
constexpr float EPS = 1e-6f;
constexpr float LOG2E = 1.4426950408889634f;
constexpr float QSCALE = 0.08838834764831845f * LOG2E;
constexpr int NTHREADS = 512, NWAVES = 8;

typedef __bf16 bf16x2_t __attribute__((ext_vector_type(2)));
__device__ __forceinline__ unsigned cvtpk(float lo, float hi) { f32x2 v = {lo, hi}; bf16x2_t b = __builtin_convertvector(v, bf16x2_t); return __builtin_bit_cast(unsigned, b); }
__device__ __forceinline__ float bf2f(unsigned short v) { return __uint_as_float((unsigned)v << 16); }
__device__ __forceinline__ float bflo(unsigned w) { return __uint_as_float(w << 16); }
__device__ __forceinline__ float bfhi(unsigned w) { return __uint_as_float(w & 0xffff0000u); }
__device__ __forceinline__ unsigned short f2bf(float f) { return (unsigned short)(cvtpk(f, 0.f) & 0xffffu); }
__device__ __forceinline__ float wave_sum(float v) {
#pragma unroll
    for (int o = 1; o < 64; o <<= 1) v += shx(v, o);
    return v;
}
__device__ __forceinline__ float sigmoid_f(float x) { return __builtin_amdgcn_rcpf(1.f + __expf(-x)); }
__device__ __forceinline__ float silu_m(float x) { return x * __builtin_amdgcn_rcpf(1.f + __expf(-x)); }
__device__ __forceinline__ float softplus_f(float x) { return fmaxf(x, 0.f) + log1pf(__expf(-fabsf(x))); }
__device__ __forceinline__ float logsigmoid_f(float x) { return fminf(x, 0.f) - log1pf(__expf(-fabsf(x))); }

struct CvtItem { f32x4 v[16]; float g[16]; };
__device__ __forceinline__ void cvt_load(CvtItem& it, const float* __restrict__ W, int ldw, int c0, int nvalid, int k0, int lane, const float* __restrict__ wn) {
    const int cc = 4 * (lane & 15); const float* wp = W + (size_t)(k0 + (lane >> 4)) * ldw + c0 + cc;
#pragma unroll
    for (int i = 0; i < 16; ++i) { it.v[i] = (f32x4){0.f, 0.f, 0.f, 0.f}; if (cc < nvalid) it.v[i] = *(const f32x4*)(wp + (size_t)(4 * i) * ldw); it.g[i] = wn ? wn[k0 + 4 * i + (lane >> 4)] : 1.f; }
}
__device__ __forceinline__ void cvt_finish(const CvtItem& it, int nvalid, int k0, bf16_t* __restrict__ WT, int K, int drow0, LAS float* scr, int lane) {
    const int cc = 4 * (lane & 15);
#pragma unroll
    for (int i = 0; i < 16; ++i) { const int kk = 4 * i + (lane >> 4);
        LAS float* s = scr + kk * 65 + cc; const float g = it.g[i]; s[0] = it.v[i][0] * g; s[1] = it.v[i][1] * g; s[2] = it.v[i][2] * g; s[3] = it.v[i][3] * g; }
    asm volatile("s_waitcnt lgkmcnt(0)" ::: "memory");
    const int c = lane & 7;
#pragma unroll
    for (int j = 0; j < 8; ++j) { const int n = 8 * j + (lane >> 3); const LAS float* s = scr + (8 * c) * 65 + n;
        u32x4 o; o.x = cvtpk(s[0], s[65]); o.y = cvtpk(s[2 * 65], s[3 * 65]); o.z = cvtpk(s[4 * 65], s[5 * 65]); o.w = cvtpk(s[6 * 65], s[7 * 65]);
        if (n < nvalid) *(u32x4*)(WT + (size_t)(drow0 + n) * K + k0 + 8 * c) = o; }
    asm volatile("s_waitcnt lgkmcnt(0)" ::: "memory");
}
__device__ __forceinline__ void cvt_matrix(const float* W, int ldw, int col0, int ncols, int K, bf16_t* WT, int dmode, int drow_off, LAS float* scr, int gw, int ngw, int lane, const float* wn = nullptr) {
    const int nb = (ncols + 63) >> 6, items = (K >> 6) * nb;
#define CVT_DECODE(it_) const int kb = (it_) / nb, nbk = (it_) - kb * nb, n0 = nbk << 6; const int nvalid = (ncols - n0) < 64 ? (ncols - n0) : 64; \
        const int drow0 = dmode == 0 ? drow_off + n0 : ((n0 >> 7) << 8) + (n0 & 127) + (dmode == 2 ? 128 : 0);
    CvtItem A, B;
    int it = gw;
    if (it < items) { CVT_DECODE(it) (void)drow0; cvt_load(A, W, ldw, col0 + n0, nvalid, kb << 6, lane, wn); }
    for (; it < items; it += 2 * ngw) {
        if (it + ngw < items) { CVT_DECODE(it + ngw) (void)drow0; cvt_load(B, W, ldw, col0 + n0, nvalid, kb << 6, lane, wn); }
        { CVT_DECODE(it) cvt_finish(A, nvalid, kb << 6, WT, K, drow0, scr, lane); }
        if (it + 2 * ngw < items) { CVT_DECODE(it + 2 * ngw) (void)drow0; cvt_load(A, W, ldw, col0 + n0, nvalid, kb << 6, lane, wn); }
        if (it + ngw < items) { CVT_DECODE(it + ngw) cvt_finish(B, nvalid, kb << 6, WT, K, drow0, scr, lane); }
    }
#undef CVT_DECODE
}

template <bool OUTF, bool COPY = false> __device__ __forceinline__ void norm_rows(const float* __restrict__ X, const float* __restrict__ w, bf16_t* __restrict__ Ob, float* __restrict__ Of, int gw, int ngw, int lane, float* __restrict__ Cp = nullptr) {
    for (int m0 = gw * 4; m0 < M; m0 += ngw * 4) {
        f32x4 v[4][8]; float s[4] = {0.f, 0.f, 0.f, 0.f};
#pragma unroll
        for (int q = 0; q < 4; ++q) { const f32x4* xr = (const f32x4*)(X + (size_t)(m0 + q) * DM) + lane;
#pragma unroll
            for (int j = 0; j < 8; ++j) v[q][j] = xr[64 * j]; }
#pragma unroll
        for (int q = 0; q < 4; ++q) { const int m = m0 + q;
#pragma unroll
            for (int j = 0; j < 8; ++j) { s[q] += (v[q][j][0] * v[q][j][0] + v[q][j][1] * v[q][j][1]) + (v[q][j][2] * v[q][j][2] + v[q][j][3] * v[q][j][3]);
                if (COPY) *((f32x4*)(Cp + (size_t)m * DM) + lane + 64 * j) = v[q][j]; }
            const float r = rsqrtf(wave_sum(s[q]) * (1.f / DM) + EPS);
#pragma unroll
            for (int j = 0; j < 8; ++j) { const f32x4 ww = *((const f32x4*)w + lane + 64 * j); const f32x4 o = v[q][j] * r * ww;
                if (OUTF) *((f32x4*)(Of + (size_t)m * DM) + lane + 64 * j) = o;
                else { u32x2 p; p.x = cvtpk(o[0], o[1]); p.y = cvtpk(o[2], o[3]); *((u32x2*)(Ob + (size_t)m * DM) + lane + 64 * j) = p; } } }
    }
}

template <bool OUTF, int R = 4> __device__ __forceinline__ void norm_rows_b(const bf16_t* __restrict__ X, const float* __restrict__ w, bf16_t* __restrict__ Ob, float* __restrict__ Of, int gw, int ngw, int lane) {
    for (int m0 = gw * R; m0 < M; m0 += ngw * R) {
        u32x4 v[R][4];
#pragma unroll
        for (int q = 0; q < R; ++q)
#pragma unroll
            for (int j = 0; j < 4; ++j) v[q][j] = *(const u32x4*)(X + (size_t)(m0 + q) * DM + j * 512 + lane * 8);
#pragma unroll
        for (int q = 0; q < R; ++q) { const int m = m0 + q; float f[4][8]; float s = 0.f;
#pragma unroll
            for (int j = 0; j < 4; ++j) { const u32x4 x = v[q][j]; f[j][0] = bflo(x.x); f[j][1] = bfhi(x.x); f[j][2] = bflo(x.y); f[j][3] = bfhi(x.y); f[j][4] = bflo(x.z); f[j][5] = bfhi(x.z); f[j][6] = bflo(x.w); f[j][7] = bfhi(x.w);
#pragma unroll
                for (int i = 0; i < 8; ++i) s += f[j][i] * f[j][i]; }
            const float r = rsqrtf(wave_sum(s) * (1.f / DM) + EPS);
#pragma unroll
            for (int j = 0; j < 4; ++j) { const f32x4 w0 = *(const f32x4*)(w + j * 512 + lane * 8), w1 = *(const f32x4*)(w + j * 512 + lane * 8 + 4);
                const f32x4 o0 = (f32x4){f[j][0], f[j][1], f[j][2], f[j][3]} * r * w0, o1 = (f32x4){f[j][4], f[j][5], f[j][6], f[j][7]} * r * w1;
                if (OUTF) { *(f32x4*)(Of + (size_t)m * DM + j * 512 + lane * 8) = o0; *(f32x4*)(Of + (size_t)m * DM + j * 512 + lane * 8 + 4) = o1; }
                else { u32x4 p; p.x = cvtpk(o0[0], o0[1]); p.y = cvtpk(o0[2], o0[3]); p.z = cvtpk(o1[0], o1[1]); p.w = cvtpk(o1[2], o1[3]); *(u32x4*)(Ob + (size_t)m * DM + j * 512 + lane * 8) = p; } } }
    }
}

__device__ __forceinline__ void prologue_rows(const float* __restrict__ X, bf16_t* __restrict__ XB, float* __restrict__ RSSc, int gw, int ngw, int lane) {
    for (int m0 = gw * 2; m0 < M; m0 += ngw * 2) { f32x4 v[2][8];
#pragma unroll
        for (int q = 0; q < 2; ++q)
#pragma unroll
            for (int j = 0; j < 8; ++j) v[q][j] = *((const f32x4*)(X + (size_t)(m0 + q) * DM) + lane + 64 * j);
#pragma unroll
        for (int q = 0; q < 2; ++q) { const int m = m0 + q; float s = 0.f;
#pragma unroll
            for (int j = 0; j < 8; ++j) { s += (v[q][j][0] * v[q][j][0] + v[q][j][1] * v[q][j][1]) + (v[q][j][2] * v[q][j][2] + v[q][j][3] * v[q][j][3]);
                u32x2 p; p.x = cvtpk(v[q][j][0], v[q][j][1]); p.y = cvtpk(v[q][j][2], v[q][j][3]); *((u32x2*)(XB + (size_t)m * DM) + lane + 64 * j) = p; }
            s = wave_sum(s);
            if (lane < 32) RSSc[(size_t)m * 32 + lane] = lane == 0 ? s : 0.f; } }
}
namespace att {
constexpr int NW = 8, QBLK = 32, KVBLK = 64;
constexpr int SHM_V = 16384, SHM_K = 16384;
constexpr int OFF_K = 2 * SHM_V, OFF_WS = OFF_K + 2 * SHM_K, OFF_CK = OFF_WS + NW * 64 * 4, LDS_ATT = OFF_CK + 2 * 256;
constexpr float THR = 8.f;
#define KSWZ(row, colB) ((row) * 256 + ((colB) ^ (((row) & 7) << 4)))
#define SBAR() __builtin_amdgcn_sched_barrier(0)
__device__ __forceinline__ int crow(int r, int hi) { return (r & 3) + 8 * (r >> 2) + 4 * hi; }
template <int MODE> __device__ __forceinline__ void maskp(f32x16& p0, f32x16& p1, int t, int NT, int qb, int wid, int qrel, int hi) {
    const float NEG = -INFINITY;
    if (MODE == 0) { if (t > 4 * qb + (wid >> 1)) {
#pragma unroll
            for (int r = 0; r < 16; ++r) { p0[r] = NEG; p1[r] = NEG; } } }
    else { if (t >= NT - 4) { const int d = qrel - (64 * (t - (NT - 4)) + 4 * hi);
#pragma unroll
            for (int r = 0; r < 16; ++r) { const int c = (r & 3) + 8 * (r >> 2); p0[r] = (c > d) ? NEG : p0[r]; p1[r] = (c + 32 > d) ? NEG : p1[r]; } } }
}
__device__ __forceinline__ void partialSM(f32x16& p0, f32x16& p1, float& m_reg, float& alpha) {
    float pmax = p0[0];
#pragma unroll
    for (int r = 1; r < 16; ++r) pmax = fmaxf(pmax, p0[r]);
#pragma unroll
    for (int r = 0; r < 16; ++r) pmax = fmaxf(pmax, p1[r]);
    { auto rr = __builtin_amdgcn_permlane32_swap(__float_as_uint(pmax), __float_as_uint(pmax), false, false);
      pmax = fmaxf(__uint_as_float(rr[0]), __uint_as_float(rr[1])); }
    float mn;
    if (__builtin_expect(__all(pmax - m_reg <= THR), 1)) { mn = m_reg; alpha = 1.f; }
    else { mn = fmaxf(m_reg, pmax); alpha = __builtin_amdgcn_exp2f(m_reg - mn); m_reg = mn; }
#pragma unroll
    for (int r = 0; r < 16; ++r) p0[r] = p0[r] - mn;
#pragma unroll
    for (int r = 0; r < 16; ++r) p1[r] = p1[r] - mn;
#pragma unroll
    for (int r = 0; r < 16; ++r) p0[r] = __builtin_amdgcn_exp2f(p0[r]);
}
__device__ __forceinline__ void finishSM(f32x16& p0, f32x16& p1, float alpha, float& l_reg, bf16x8& pa0, bf16x8& pa1, bf16x8& pa2, bf16x8& pa3) {
#pragma unroll
    for (int r = 0; r < 16; ++r) p1[r] = __builtin_amdgcn_exp2f(p1[r]);
    float ps = 0;
#pragma unroll
    for (int r = 0; r < 16; ++r) ps += p0[r];
#pragma unroll
    for (int r = 0; r < 16; ++r) ps += p1[r];
    { auto rr = __builtin_amdgcn_permlane32_swap(__float_as_uint(ps), __float_as_uint(ps), false, false);
      ps = __uint_as_float(rr[0]) + __uint_as_float(rr[1]); }
    l_reg = l_reg * alpha + ps;
#define PK4(P, BASE, OUT) do { unsigned a0 = cvtpk(P[BASE + 0], P[BASE + 1]), a1 = cvtpk(P[BASE + 2], P[BASE + 3]);   \
    unsigned b0 = cvtpk(P[BASE + 4], P[BASE + 5]), b1 = cvtpk(P[BASE + 6], P[BASE + 7]);                              \
    auto r0 = __builtin_amdgcn_permlane32_swap(a0, b0, false, false); auto r1 = __builtin_amdgcn_permlane32_swap(a1, b1, false, false); \
    u32x4 w = {r0[0], r1[0], r0[1], r1[1]}; OUT = *reinterpret_cast<bf16x8*>(&w); } while (0)
    PK4(p0, 0, pa0); PK4(p0, 8, pa1); PK4(p1, 0, pa2); PK4(p1, 8, pa3);
#undef PK4
}
template <int MODE> __device__ __forceinline__ void qkt(f32x16& p0, f32x16& p1, const char* Ks, const float* ckl, const bf16x8* qr, int r32, int hi) {
    if (MODE == 1) {
#pragma unroll
        for (int i = 0; i < 4; ++i) { const f32x4 a = *(const f32x4*)(ckl + 8 * i + 4 * hi), b = *(const f32x4*)(ckl + 32 + 8 * i + 4 * hi);
            p0[4 * i] = a[0]; p0[4 * i + 1] = a[1]; p0[4 * i + 2] = a[2]; p0[4 * i + 3] = a[3];
            p1[4 * i] = b[0]; p1[4 * i + 1] = b[1]; p1[4 * i + 2] = b[2]; p1[4 * i + 3] = b[3]; }
    } else { p0 = f32x16{}; p1 = f32x16{}; }
#pragma unroll
    for (int d0 = 0; d0 < 8; ++d0) { const int cb = (d0 * 16 + hi * 8) * 2;
        bf16x8 b0 = *reinterpret_cast<const bf16x8*>(Ks + KSWZ(r32, cb));
        bf16x8 b1 = *reinterpret_cast<const bf16x8*>(Ks + KSWZ(32 + r32, cb));
        p0 = __builtin_amdgcn_mfma_f32_32x32x16_bf16(b0, qr[d0], p0, 0, 0, 0);
        p1 = __builtin_amdgcn_mfma_f32_32x32x16_bf16(b1, qr[d0], p1, 0, 0, 0); }
}
__device__ __forceinline__ int v_st(int k, int c) { const int kk = (k & ~0xC) | ((k & 4) << 1) | ((k & 8) >> 1); return ((kk >> 3) * 4 + (c >> 5)) * 512 + ((kk & 7) * 32 + (c & 31)) * 2; }
__device__ __forceinline__ int v_rd_base(int lane) { return ((lane & 3) << 3) | (((lane >> 2) & 3) << 6) | (((lane >> 4) & 1) << 5) | (((lane >> 5) & 1) << 8); }
constexpr int v_rd_off(int d0, int ks, int half) { return d0 * 512 + ks * 4096 + half * 2048; }
template <int OFF> __device__ __forceinline__ s16x4 tr_read(int vb) {
    s16x4 r; asm volatile("ds_read_b64_tr_b16 %0, %1 offset:%2" : "=&v"(r) : "v"(vb), "i"(OFF) : "memory"); return r;
}
template <int D0> __device__ __forceinline__ void pv_one(f32x16& od, int vb, bf16x8 pa0, bf16x8 pa1, bf16x8 pa2, bf16x8 pa3) {
    const s16x4 l0 = tr_read<v_rd_off(D0, 0, 0)>(vb), h0 = tr_read<v_rd_off(D0, 0, 1)>(vb), l1 = tr_read<v_rd_off(D0, 1, 0)>(vb), h1 = tr_read<v_rd_off(D0, 1, 1)>(vb);
    const s16x4 l2 = tr_read<v_rd_off(D0, 2, 0)>(vb), h2 = tr_read<v_rd_off(D0, 2, 1)>(vb), l3 = tr_read<v_rd_off(D0, 3, 0)>(vb), h3 = tr_read<v_rd_off(D0, 3, 1)>(vb);
    asm volatile("s_waitcnt lgkmcnt(0)" ::: "memory"); SBAR();
#define PK(L, H) (bf16x8){L[0], L[1], L[2], L[3], H[0], H[1], H[2], H[3]}
    od = __builtin_amdgcn_mfma_f32_32x32x16_bf16(pa0, PK(l0, h0), od, 0, 0, 0);
    od = __builtin_amdgcn_mfma_f32_32x32x16_bf16(pa1, PK(l1, h1), od, 0, 0, 0);
    od = __builtin_amdgcn_mfma_f32_32x32x16_bf16(pa2, PK(l2, h2), od, 0, 0, 0);
    od = __builtin_amdgcn_mfma_f32_32x32x16_bf16(pa3, PK(l3, h3), od, 0, 0, 0);
#undef PK
}
__device__ __forceinline__ void pv_d0(f32x16* o, int vb, bf16x8 pa0, bf16x8 pa1, bf16x8 pa2, bf16x8 pa3) {
    pv_one<0>(o[0], vb, pa0, pa1, pa2, pa3); pv_one<1>(o[1], vb, pa0, pa1, pa2, pa3); pv_one<2>(o[2], vb, pa0, pa1, pa2, pa3); pv_one<3>(o[3], vb, pa0, pa1, pa2, pa3);
}
template <int MODE, int LD, int SD>
__device__ __forceinline__ void attn_unit(const bf16_t* __restrict__ Qb, const bf16_t* __restrict__ Kh, const bf16_t* __restrict__ Vh, int qb,
                                          const float* __restrict__ nck, float* __restrict__ Of, bf16_t* __restrict__ Ob, const bf16_t* __restrict__ Gb, char* lds, int wv) {
    const int tid = tidw(wv), wid = wv, lane = tid & 63, r32 = lane & 31, hi = lane >> 5;
    char* V_lds = lds; char* K_lds = lds + OFF_K;
    float* ws = (float*)(lds + OFF_WS) + wid * 64; float* li_l = ws; float* al_l = ws + 32;
    float* ck_lds = (float*)(lds + OFF_CK);
    float m_reg = -1e30f, l_reg = 0; f32x16 o[4] = {}; bf16x8 qr[8];
    const bf16_t* Qw = Qb + (long)(wid * QBLK + r32) * LD + hi * 8;
#pragma unroll
    for (int d0 = 0; d0 < 8; ++d0) qr[d0] = *reinterpret_cast<const bf16x8*>(Qw + d0 * 16);
    const int sr = tid >> 4, sc = (tid & 15) * 8, vst0 = v_st(sr, sc), vst1 = v_st(32 + sr, sc);
    const int vb0 = (int)(uintptr_t)V_lds + v_rd_base(lane);
    struct { bf16x8 vs0, vs1, ks0, ks1; float ck; } sr_[SD];
#define SLOAD(i, k0) do { sr_[i].vs0 = *reinterpret_cast<const bf16x8*>(&Vh[(long)((k0) + sr) * LD + sc]); sr_[i].vs1 = *reinterpret_cast<const bf16x8*>(&Vh[(long)((k0) + 32 + sr) * LD + sc]); \
    sr_[i].ks0 = *reinterpret_cast<const bf16x8*>(&Kh[(long)((k0) + sr) * LD + sc]); sr_[i].ks1 = *reinterpret_cast<const bf16x8*>(&Kh[(long)((k0) + 32 + sr) * LD + sc]); \
    if (MODE == 1) { if (tid < 64) sr_[i].ck = nck[(k0) + tid]; } } while (0)
#define SWRITE(b, i) do { *(bf16x8*)(V_lds + (b) * SHM_V + vst0) = sr_[i].vs0;          \
    *(bf16x8*)(V_lds + (b) * SHM_V + vst1) = sr_[i].vs1; const int kc = sc * 2;               \
    *(bf16x8*)(K_lds + (b) * SHM_K + KSWZ(sr, kc)) = sr_[i].ks0;                       \
    *(bf16x8*)(K_lds + (b) * SHM_K + KSWZ(32 + sr, kc)) = sr_[i].ks1; \
    if (MODE == 1) { if (tid < 64) ck_lds[(b) * 64 + tid] = sr_[i].ck; } } while (0)
#define SWAIT() do { if (SD == 2) asm volatile("s_waitcnt vmcnt(4)" ::: "memory"); else asm volatile("s_waitcnt vmcnt(0)" ::: "memory"); } while (0)
#define RESC(a) do { if (__any((a) < 1.f)) { if (hi == 0) al_l[r32] = (a); asm volatile("s_waitcnt lgkmcnt(0)" ::: "memory"); \
    _Pragma("unroll") for (int d = 0; d < 4; ++d) _Pragma("unroll") for (int r = 0; r < 16; ++r) o[d][r] *= al_l[crow(r, hi)]; } } while (0)
    f32x16 pA0, pA1, pB0, pB1; float alA, alB; bf16x8 pa0, pa1, pa2, pa3; const int NT = 4 * qb + 4;
    const int qrel = wid * QBLK + r32;
    constexpr int SE = 0, SO = SD - 1;
    SLOAD(SE, 0); asm volatile("s_waitcnt vmcnt(0)" ::: "memory"); SWRITE(0, SE); __syncthreads();
    qkt<MODE>(pA0, pA1, K_lds, ck_lds, qr, r32, hi); maskp<MODE>(pA0, pA1, 0, NT, qb, wid, qrel, hi); partialSM(pA0, pA1, m_reg, alA);
    SLOAD(SO, KVBLK); if (SD == 2) { if (2 < NT) SLOAD(SE, 2 * KVBLK); }
    SWAIT(); SWRITE(1, SO); __syncthreads();
    for (int j = 1; j + 1 < NT; j += 2) {
        SBAR(); qkt<MODE>(pB0, pB1, K_lds + SHM_K, ck_lds + 64, qr, r32, hi); maskp<MODE>(pB0, pB1, j, NT, qb, wid, qrel, hi);
        finishSM(pA0, pA1, alA, l_reg, pa0, pa1, pa2, pa3); SBAR();
        SLOAD(SO, (j + SD) * KVBLK); SBAR();
        pv_d0(o, vb0, pa0, pa1, pa2, pa3); partialSM(pB0, pB1, m_reg, alB);
        __syncthreads(); SWAIT(); SWRITE(0, SE);
        RESC(alB); __syncthreads();
        SBAR(); qkt<MODE>(pA0, pA1, K_lds, ck_lds, qr, r32, hi); maskp<MODE>(pA0, pA1, j + 1, NT, qb, wid, qrel, hi);
        finishSM(pB0, pB1, alB, l_reg, pa0, pa1, pa2, pa3); SBAR();
        if (SD == 1 || j + 3 < NT) SLOAD(SE, (j + 1 + SD) * KVBLK); SBAR();
        pv_d0(o, vb0 + SHM_V, pa0, pa1, pa2, pa3); partialSM(pA0, pA1, m_reg, alA);
        __syncthreads(); SWAIT(); SWRITE(1, SO);
        RESC(alA); __syncthreads();
    }
    SBAR(); qkt<MODE>(pB0, pB1, K_lds + SHM_K, ck_lds + 64, qr, r32, hi); maskp<MODE>(pB0, pB1, NT - 1, NT, qb, wid, qrel, hi);
    finishSM(pA0, pA1, alA, l_reg, pa0, pa1, pa2, pa3); SBAR();
    pv_d0(o, vb0, pa0, pa1, pa2, pa3); partialSM(pB0, pB1, m_reg, alB);
    __syncthreads(); RESC(alB);
    finishSM(pB0, pB1, alB, l_reg, pa0, pa1, pa2, pa3); SBAR();
    pv_d0(o, vb0 + SHM_V, pa0, pa1, pa2, pa3);
    if (hi == 0) li_l[r32] = l_reg; asm volatile("s_waitcnt lgkmcnt(0)" ::: "memory");
    float rli[16];
#pragma unroll
    for (int r = 0; r < 16; ++r) rli[r] = __builtin_amdgcn_rcpf(li_l[crow(r, hi)]);
    if (MODE == 0) { float* Ow = Of + (long)(wid * QBLK) * 2048;
#pragma unroll
        for (int r = 0; r < 16; ++r) { const int orow = crow(r, hi);
#pragma unroll
            for (int d0 = 0; d0 < 4; ++d0) Ow[(long)orow * 2048 + d0 * 32 + r32] = o[d0][r] * rli[r]; } }
    else { bf16_t* Ow = Ob + (long)(wid * QBLK) * 2048; const bf16_t* Gw = Gb + (long)(wid * QBLK) * LD;
#pragma unroll
        for (int r = 0; r < 16; ++r) { const int orow = crow(r, hi);
#pragma unroll
            for (int d0 = 0; d0 < 4; ++d0) { const float g = bf2f(Gw[(long)orow * LD + d0 * 32 + r32]);
                Ow[(long)orow * 2048 + d0 * 32 + r32] = f2bf(o[d0][r] * rli[r] * sigmoid_f(g)); } } }
    __syncthreads();
#undef SLOAD
#undef SWRITE
#undef SWAIT
#undef RESC
}
#undef SBAR
}
#define LAS __attribute__((address_space(3)))
#define XB_TMO      128
#define XB_XCNT(j)  (256  + 64 * (j))
#define XB_XSUB(j)  (1280 + 64 * (j))
#define XB_XGEN(j)  (2304 + 64 * (j))
#define XB_TOP      3328
#define XB_TOPGEN   3392
#define XCD_BAR_WORDS 3456
#define XB_SPIN_CAP (1u << 18)

__device__ __forceinline__ unsigned xb_ld(unsigned* p)              { return __hip_atomic_load(p, __ATOMIC_RELAXED, __HIP_MEMORY_SCOPE_AGENT); }
__device__ __forceinline__ unsigned xb_add(unsigned* p, unsigned v) { return __hip_atomic_fetch_add(p, v, __ATOMIC_RELAXED, __HIP_MEMORY_SCOPE_AGENT); }
__device__ __forceinline__ unsigned xb_xcc_id() { return (unsigned)__builtin_amdgcn_s_getreg((3 << 11) | 20) & 0xFu; }
#define XB_SPIN(cond, bar) do { unsigned _sp = 0; while (cond) { __builtin_amdgcn_s_sleep(1); \
    if ((++_sp & 255u) == 0u) { if (xb_ld(&(bar)[XB_TMO])) break; if (_sp > XB_SPIN_CAP) { atomicAdd(&(bar)[XB_TMO], 1u); break; } } } } while (0)

struct XcdBarrier {
    unsigned* bar; unsigned x;
    volatile LAS unsigned* st;
};

__device__ __forceinline__ XcdBarrier xcd_barrier_post(unsigned* bar, volatile LAS unsigned* st) {
    XcdBarrier b; b.bar = bar; b.x = xb_xcc_id(); b.st = st;
    if (threadIdx.x == 0) (void)xb_add(&bar[XB_XCNT(b.x)], 1u);
    return b;
}
__device__ __forceinline__ void xcd_barrier_complete(unsigned* bar, unsigned x, unsigned& nloc, unsigned& nx) {
    const unsigned G = gridDim.x * gridDim.y * gridDim.z;
    unsigned sum, cnt, mine, sp = 0u;
    for (;;) {
        sum = 0u; cnt = 0u; mine = 0u;
#pragma unroll
        for (unsigned j = 0; j < 16; ++j) { const unsigned c = xb_ld(&bar[XB_XCNT(j)]); sum += c; cnt += (c > 0u) ? 1u : 0u; mine = (j == x) ? c : mine; }
        if (sum == G) break;
        __builtin_amdgcn_s_sleep(1);
        if ((++sp & 255u) == 0u) { if (xb_ld(&bar[XB_TMO])) break; if (sp > XB_SPIN_CAP) { atomicAdd(&bar[XB_TMO], 1u); break; } }
    }
    nloc = mine > 0u ? mine : 1u; nx = cnt > 0u ? cnt : 1u;
}

__device__ __forceinline__ void xcd_barrier(const XcdBarrier& b) {
    asm volatile("s_waitcnt vmcnt(0)" ::: "memory");
    __syncthreads();
    if (threadIdx.x == 0) {
        unsigned* bar = b.bar;
        __builtin_amdgcn_s_waitcnt(0);
        unsigned nloc = b.st[0], nx = b.st[1];
        if (nloc == 0u) { xcd_barrier_complete(bar, b.x, nloc, nx); b.st[0] = nloc; b.st[1] = nx; }
        const unsigned old = xb_add(&bar[XB_XSUB(b.x)], 1u);
        const unsigned gen = old / nloc;
        if (old + 1u == (gen + 1u) * nloc) {
            __builtin_amdgcn_fence(__ATOMIC_RELEASE, "agent");
            asm volatile("s_waitcnt vmcnt(0)" ::: "memory");
            const unsigned og = xb_add(&bar[XB_TOP], 1u);
            const unsigned tg = og / nx;
            if (og + 1u == (tg + 1u) * nx) xb_add(&bar[XB_TOPGEN], 1u);
            else XB_SPIN(xb_ld(&bar[XB_TOPGEN]) == tg, bar);
            __builtin_amdgcn_fence(__ATOMIC_ACQUIRE, "agent");
            xb_add(&bar[XB_XGEN(b.x)], 1u);
            asm volatile("s_waitcnt vmcnt(0)" ::: "memory");
        } else {
            XB_SPIN(xb_ld(&bar[XB_XGEN(b.x)]) == gen, bar);
            __builtin_amdgcn_fence(__ATOMIC_ACQUIRE, "agent");
            asm volatile("s_waitcnt vmcnt(0)" ::: "memory");
        }
    }
    __syncthreads();
}

__device__ __forceinline__ void fox_qknorm(bf16_t* P, const float* qn, const float* kn, int gw, int ngw, int lane) {
    const int dl = (lane & 15) * 8;
    const f32x4 q0 = *(const f32x4*)(qn + dl), q1 = *(const f32x4*)(qn + dl + 4), k0 = *(const f32x4*)(kn + dl), k1 = *(const f32x4*)(kn + dl + 4);
    for (int it0 = gw * 8; it0 < 2 * M; it0 += ngw * 8) {
        u32x4 xs[8][4];
#pragma unroll
        for (int q = 0; q < 8; ++q) { const int it = it0 + q; const bf16_t* row = P + (size_t)(it >> 1) * 8192 + (it & 1) * 2048;
#pragma unroll
            for (int j = 0; j < 4; ++j) xs[q][j] = *(const u32x4*)(row + j * 512 + lane * 8); }
#pragma unroll
        for (int q = 0; q < 8; ++q) { const int it = it0 + q, isk = it & 1; bf16_t* row = P + (size_t)(it >> 1) * 8192 + isk * 2048;
            const f32x4 w0 = isk ? k0 : q0, w1 = isk ? k1 : q1; const float mul = isk ? 1.f : QSCALE;
#pragma unroll
            for (int j = 0; j < 4; ++j) { const u32x4 x = xs[q][j];
                float f[8] = {bflo(x.x), bfhi(x.x), bflo(x.y), bfhi(x.y), bflo(x.z), bfhi(x.z), bflo(x.w), bfhi(x.w)};
                float s = 0.f;
#pragma unroll
                for (int i = 0; i < 8; ++i) s += f[i] * f[i];
                s += shx(s, 1); s += shx(s, 2); s += shx(s, 4); s += shx(s, 8);
                const float r = rsqrtf(s * (1.f / 128.f) + EPS) * mul;
                u32x4 o; o.x = cvtpk(f[0] * r * w0[0], f[1] * r * w0[1]); o.y = cvtpk(f[2] * r * w0[2], f[3] * r * w0[3]);
                o.z = cvtpk(f[4] * r * w1[0], f[5] * r * w1[1]); o.w = cvtpk(f[6] * r * w1[2], f[7] * r * w1[3]);
                *(u32x4*)(row + j * 512 + lane * 8) = o; } } }
}
__device__ __forceinline__ void fox_cumsum(const float* XF  , const float* bias, float* NCK, int hd, LAS float* scr, int tid) {
    const float b = bias[hd]; float v[16]; float run = 0.f;
    float fs[16];
#pragma unroll
    for (int i = 0; i < 16; ++i) fs[i] = 0.f;
#pragma unroll
    for (int ks = 0; ks < 8; ++ks) { const f32x4* p = (const f32x4*)(XF + (size_t)ks * M * 64 + (size_t)hd * M + tid * 16);
#pragma unroll
        for (int q = 0; q < 4; ++q) { const f32x4 t = p[q]; fs[4 * q] += t[0]; fs[4 * q + 1] += t[1]; fs[4 * q + 2] += t[2]; fs[4 * q + 3] += t[3]; } }
#pragma unroll
    for (int i = 0; i < 16; ++i) { run += logsigmoid_f(fs[i] + b); v[i] = run; }
    float inc = run; const int lane = tid & 63, wid = tid >> 6;
#pragma unroll
    for (int o = 1; o < 64; o <<= 1) { const float t = shup(inc, o); if (lane >= o) inc += t; }
    if (lane == 63) scr[wid] = inc;
    __syncthreads();
    float base = inc - run;
    for (int w = 0; w < wid; ++w) base += scr[w];
#pragma unroll
    for (int i = 0; i < 16; ++i) NCK[(size_t)hd * M + tid * 16 + i] = -(base + v[i]) * LOG2E;
    __syncthreads();
}
__device__ __forceinline__ void diff_combine(const float* O0, const float* O1, const float* q1, const float* k1, const float* q2, const float* k2, const float* sub, float lam_init,
                                             bf16_t* MIX, int gw, int ngw, int lane) {
    const float s1 = wave_sum(q1[lane] * k1[lane] + q1[lane + 64] * k1[lane + 64]), s2 = wave_sum(q2[lane] * k2[lane] + q2[lane + 64] * k2[lane + 64]);
    const float lam = __expf(s1) - __expf(s2) + lam_init; const float post = 1.f - lam_init;
    const f32x4 sw = *((const f32x4*)sub + lane);
    for (int it0 = gw * 8; it0 < M * 8; it0 += ngw * 8) {
        f32x4 a[8], b[8];
#pragma unroll
        for (int q = 0; q < 8; ++q) { const size_t off = (size_t)(it0 + q) * 256 + lane * 4; a[q] = *(const f32x4*)(O0 + off); b[q] = *(const f32x4*)(O1 + off); }
#pragma unroll
        for (int q = 0; q < 8; ++q) { const size_t off = (size_t)(it0 + q) * 256 + lane * 4; const f32x4 d = a[q] - lam * b[q];
            const float ss = wave_sum((d[0] * d[0] + d[1] * d[1]) + (d[2] * d[2] + d[3] * d[3]));
            const float r = rsqrtf(ss * (1.f / 256.f) + EPS) * post; const f32x4 o = d * r * sw;
            u32x2 p; p.x = cvtpk(o[0], o[1]); p.y = cvtpk(o[2], o[3]); *(u32x2*)(MIX + off) = p; } }
}
__device__ __forceinline__ void gdn_post(const bf16_t* OG, const bf16_t* Z, const float* onw, bf16_t* MIX, int gw, int ngw, int lane) {
    const int dl = (lane & 15) * 8; const f32x4 w0 = *(const f32x4*)(onw + dl), w1 = *(const f32x4*)(onw + dl + 4);
    const float w[8] = {w0[0], w0[1], w0[2], w0[3], w1[0], w1[1], w1[2], w1[3]};
    for (int it0 = gw * 8; it0 < M * 8; it0 += ngw * 8) {
        u32x4 xs[8], zs[8];
#pragma unroll
        for (int q = 0; q < 8; ++q) { const int it = it0 + q; const size_t off = (size_t)it * 512 + lane * 8;
            const int tok_ = it >> 3, hv_ = (it & 7) * 4 + (lane >> 4), j_ = lane & 15;
            xs[q] = *(const u32x4*)(OG + ((size_t)(((tok_ >> 6) * 32 + hv_) * 8 + (j_ >> 1)) * 64 + (tok_ & 63)) * 16 + 8 * (j_ & 1)); zs[q] = *(const u32x4*)(Z + off); }
#pragma unroll
        for (int q = 0; q < 8; ++q) { const size_t off = (size_t)(it0 + q) * 512 + lane * 8; const u32x4 x = xs[q], z = zs[q];
            const float f[8] = {bflo(x.x), bfhi(x.x), bflo(x.y), bfhi(x.y), bflo(x.z), bfhi(x.z), bflo(x.w), bfhi(x.w)};
            const float g[8] = {bflo(z.x), bfhi(z.x), bflo(z.y), bfhi(z.y), bflo(z.z), bfhi(z.z), bflo(z.w), bfhi(z.w)};
            float s = 0.f;
#pragma unroll
            for (int i = 0; i < 8; ++i) s += f[i] * f[i];
            s += shx(s, 1); s += shx(s, 2); s += shx(s, 4); s += shx(s, 8);
            const float r = rsqrtf(s * (1.f / 128.f) + EPS); float o[8];
#pragma unroll
            for (int i = 0; i < 8; ++i) o[i] = f[i] * r * w[i] * silu_m(g[i]);
            u32x4 p; p.x = cvtpk(o[0], o[1]); p.y = cvtpk(o[2], o[3]); p.z = cvtpk(o[4], o[5]); p.w = cvtpk(o[6], o[7]);
            *(u32x4*)(MIX + off) = p; } }
}

namespace gdn {
constexpr int QSTR = 136;
constexpr int OFF_QS = 0, OFF_KS = OFF_QS + 64 * QSTR * 2, OFF_VS = OFF_KS + 64 * QSTR * 2, OFF_KK = OFF_VS + 64 * 256 * 2, OFF_QK = OFF_KK + 16384, OFF_T1 = OFF_QK + 16384,
              OFF_SM = OFF_T1 + 16384, LDS_PREP = OFF_SM + 6 * 64 * 4;
struct TRow { f32x4 t[16]; };
template <int I> __device__ __forceinline__ void load_trow(TRow& R, const LAS float* T) {
#pragma unroll
    for (int jb = 0; jb < 16; ++jb) if (4 * jb < I) R.t[jb] = *(const LAS f32x4*)(T + I * 64 + 4 * jb);
}
struct TRow8 { f32x4 t[8]; };
template <int I> __device__ __forceinline__ void load_trow8(TRow8& R, const LAS float* T) {
#pragma unroll
    for (int jb = 0; jb < 8; ++jb) if (4 * jb < I) R.t[jb] = *(const LAS f32x4*)(T + I * 64 + 4 * jb);
}
template <int I> __device__ __forceinline__ void solve_rows(f32x2 (&xp)[32], const LAS float* T, const TRow8& cur) {
    if constexpr (I < 64) {
        TRow8 nxt;
        if constexpr (I + 1 < 64) load_trow8<I + 1>(nxt, T);
        asm volatile("" ::: "memory"); __builtin_amdgcn_sched_barrier(0);
        f32x2 r2 = {xp[I >> 1][I & 1], 0.f};
#pragma unroll
        for (int jb = 0; jb < 8; ++jb) if (4 * jb < I) {
            const f32x2 tlo = {cur.t[jb][0], cur.t[jb][1]}, thi = {cur.t[jb][2], cur.t[jb][3]};
            r2 -= tlo * xp[2 * jb];
            if (4 * jb + 2 < I) r2 -= thi * xp[2 * jb + 1]; }
#pragma unroll
        for (int jb = 8; jb < 16; ++jb) if (4 * jb < I) {
            const f32x4 tr = *(const LAS f32x4*)(T + I * 64 + 4 * jb);
            const f32x2 tlo = {tr[0], tr[1]}, thi = {tr[2], tr[3]};
            r2 -= tlo * xp[2 * jb];
            if (4 * jb + 2 < I) r2 -= thi * xp[2 * jb + 1]; }
        xp[I >> 1][I & 1] = r2[0] + r2[1];
        solve_rows<I + 1>(xp, T, nxt);
    }
}
__device__ __forceinline__ void prep_unit(int hk, int n, const bf16_t* __restrict__ RAW, const float* __restrict__ XF, const float* __restrict__ convw, const float* __restrict__ a_log, const float* __restrict__ dt_bias,
                                          bf16_t* __restrict__ QN, bf16_t* __restrict__ KT, bf16_t* __restrict__ UT, bf16_t* __restrict__ NWB, bf16_t* __restrict__ INTRA, float* __restrict__ GCG, LAS unsigned char* lds, int wv) {
    const int tid = tidw(wv), wid = wv, lane = tid & 63, t0 = n * 64;
    LAS bf16_t* QS = (LAS bf16_t*)(lds + OFF_QS); LAS bf16_t* KS = (LAS bf16_t*)(lds + OFF_KS); LAS bf16_t* VS = (LAS bf16_t*)(lds + OFF_VS);
    LAS float* KK = (LAS float*)(lds + OFF_KK); LAS float* QK = (LAS float*)(lds + OFF_QK); LAS float* T1 = (LAS float*)(lds + OFF_T1);
    LAS float* BETA = (LAS float*)(lds + OFF_SM); LAS float* GC = BETA + 128; LAS float* EGC = GC + 128;
    { const int part = lane >> 4, cg = lane & 15;
      const int ch = (part == 0 ? hk * 128 : part == 1 ? 2048 + hk * 128 : 4096 + (2 * hk + (part - 2)) * 128) + cg * 8;
      float cw[4][8];
#pragma unroll
      for (int j = 0; j < 4; ++j) { const f32x4 a = *(const f32x4*)(convw + (size_t)j * 8192 + ch), b = *(const f32x4*)(convw + (size_t)j * 8192 + ch + 4);
          cw[j][0] = a[0]; cw[j][1] = a[1]; cw[j][2] = a[2]; cw[j][3] = a[3]; cw[j][4] = b[0]; cw[j][5] = b[1]; cw[j][6] = b[2]; cw[j][7] = b[3]; }
      float x0[8], x1[8], x2[8], x3[8];
      const int tb = t0 + wid * 8;
#define LDROW(dst, t) do { if ((t) >= 0) { const u32x4 w_ = *(const u32x4*)(RAW + (size_t)(t) * 8192 + ch); dst[0] = bflo(w_.x); dst[1] = bfhi(w_.x); dst[2] = bflo(w_.y); dst[3] = bfhi(w_.y); \
          dst[4] = bflo(w_.z); dst[5] = bfhi(w_.z); dst[6] = bflo(w_.w); dst[7] = bfhi(w_.w); } else { _Pragma("unroll") for (int i_ = 0; i_ < 8; ++i_) dst[i_] = 0.f; } } while (0)
      LDROW(x0, tb - 3); LDROW(x1, tb - 2); LDROW(x2, tb - 1);
#pragma unroll
      for (int i = 0; i < 8; ++i) {
          LDROW(x3, tb + i);
          float y[8]; float ss = 0.f;
#pragma unroll
          for (int c = 0; c < 8; ++c) { const float a = cw[0][c] * x0[c] + cw[1][c] * x1[c] + cw[2][c] * x2[c] + cw[3][c] * x3[c]; y[c] = silu_m(a); ss += y[c] * y[c]; }
          ss += shx(ss, 1); ss += shx(ss, 2); ss += shx(ss, 4); ss += shx(ss, 8);
          float mul = 1.f; if (part < 2) mul = rsqrtf(ss + EPS) * (part == 0 ? 0.08838834764831845f : 1.f);
          u32x4 o; o.x = cvtpk(y[0] * mul, y[1] * mul); o.y = cvtpk(y[2] * mul, y[3] * mul); o.z = cvtpk(y[4] * mul, y[5] * mul); o.w = cvtpk(y[6] * mul, y[7] * mul);
          const int tt = wid * 8 + i;
          if (part == 0) *(LAS u32x4*)(QS + tt * QSTR + cg * 8) = o; else if (part == 1) *(LAS u32x4*)(KS + tt * QSTR + cg * 8) = o; else *(LAS u32x4*)(VS + tt * 256 + (part - 2) * 128 + cg * 8) = o;
#pragma unroll
          for (int c = 0; c < 8; ++c) { x0[c] = x1[c]; x1[c] = x2[c]; x2[c] = x3[c]; }
      }
#undef LDROW
    }
    if (tid < 128) { const int j = tid >> 6, i = tid & 63, hv = 2 * hk + j; const float* xr = XF + (size_t)(t0 + i) * 64;
        float xb = 0.f, xa = 0.f;
#pragma unroll
        for (int ks = 0; ks < 8; ++ks) { xb += xr[(size_t)ks * M * 64 + hv]; xa += xr[(size_t)ks * M * 64 + 32 + hv]; }
        const float be = sigmoid_f(xb); const float g = -__expf(a_log[hv]) * softplus_f(xa + dt_bias[hv]);
        float inc = g;
#pragma unroll
        for (int o = 1; o < 64; o <<= 1) { const float t = shup(inc, o); if (i >= o) inc += t; }
        BETA[j * 64 + i] = be; GC[j * 64 + i] = inc; EGC[j * 64 + i] = __expf(inc); GCG[(size_t)(n * 32 + hv) * 64 + i] = inc; }
    __syncthreads();
    { const int prod = wid >> 2, ti = wid & 3, g4 = lane >> 4, l15 = lane & 15; LAS bf16_t* As = prod ? QS : KS; LAS float* Out = prod ? QK : KK;
      bf16x8 af[4];
#pragma unroll
      for (int s = 0; s < 4; ++s) af[s] = *(LAS bf16x8*)(As + (16 * ti + l15) * QSTR + 32 * s + 8 * g4);
#pragma unroll
      for (int tj = 0; tj < 4; ++tj) { f32x4 acc = {0.f, 0.f, 0.f, 0.f};
#pragma unroll
          for (int s = 0; s < 4; ++s) { const bf16x8 bfg = *(LAS bf16x8*)(KS + (16 * tj + l15) * QSTR + 32 * s + 8 * g4); acc = __builtin_amdgcn_mfma_f32_16x16x32_bf16(af[s], bfg, acc, 0, 0, 0); }
#pragma unroll
          for (int r = 0; r < 4; ++r) Out[(16 * ti + 4 * g4 + r) * 64 + 16 * tj + l15] = acc[r]; } }
    __syncthreads();
    { const int i = tid >> 3, j0 = (tid & 7) * 8;
      const float gi0 = GC[i], gi1 = GC[64 + i], bi0 = BETA[i], bi1 = BETA[64 + i];
      float in0[8], in1[8];
#pragma unroll
      for (int jj = 0; jj < 8; ++jj) { const int j = j0 + jj; const float kk = KK[i * 64 + j], qk = QK[i * 64 + j];
          const float d0 = __expf(gi0 - GC[j]), d1 = __expf(gi1 - GC[64 + j]);
          T1[i * 64 + j] = (j < i) ? bi1 * kk * d1 : 0.f; KK[i * 64 + j] = (j < i) ? bi0 * kk * d0 : 0.f;
          in0[jj] = (j <= i) ? qk * d0 : 0.f; in1[jj] = (j <= i) ? qk * d1 : 0.f; }
      u32x4 p0, p1; p0.x = cvtpk(in0[0], in0[1]); p0.y = cvtpk(in0[2], in0[3]); p0.z = cvtpk(in0[4], in0[5]); p0.w = cvtpk(in0[6], in0[7]);
      p1.x = cvtpk(in1[0], in1[1]); p1.y = cvtpk(in1[2], in1[3]); p1.z = cvtpk(in1[4], in1[5]); p1.w = cvtpk(in1[6], in1[7]);
      { const int fo = (((i >> 4) * 2 + (j0 >> 5)) * 64 + (i & 15) + 16 * ((j0 & 31) >> 3)) * 8;
        *(u32x4*)(INTRA + (size_t)(n * 32 + 2 * hk) * 4096 + fo) = p0; *(u32x4*)(INTRA + (size_t)(n * 32 + 2 * hk + 1) * 4096 + fo) = p1; }
#pragma unroll
      for (int rep = 0; rep < 2; ++rep) { const int idx = tid + rep * 512, r = idx >> 4, c8 = (idx & 15) * 8; *(u32x4*)(QN + (size_t)(n * 16 + hk) * 8192 + (((r >> 4) * 4 + (c8 >> 5)) * 64 + (r & 15) + 16 * ((c8 & 31) >> 3)) * 8) = *(LAS u32x4*)(QS + r * QSTR + c8); }
      { const int d = tid & 127, cq = tid >> 7; unsigned wv[8];
#pragma unroll
        for (int c2 = 0; c2 < 8; ++c2) { const unsigned lo = KS[(16 * cq + 2 * c2) * QSTR + d], hi = KS[(16 * cq + 2 * c2 + 1) * QSTR + d]; wv[c2] = lo | (hi << 16); }
        bf16_t* dst = KT + (size_t)(n * 16 + hk) * 8192 + (((d >> 4) * 2 + (cq >> 1)) * 64 + (d & 15) + 32 * (cq & 1)) * 8;
        *(u32x4*)dst = (u32x4){wv[0], wv[1], wv[2], wv[3]}; *(u32x4*)(dst + 16 * 8) = (u32x4){wv[4], wv[5], wv[6], wv[7]}; } }
    __syncthreads();
    { const int j = tid >> 8, col = tid & 255, hv = 2 * hk + j; int toff = j ? OFF_T1 : OFF_KK; asm volatile("" : "+v"(toff)); const LAS float* T = (const LAS float*)(lds + toff);
      f32x2 xp[32];
      if (col < 128) {
#pragma unroll
          for (int i = 0; i < 64; ++i) xp[i >> 1][i & 1] = bf2f(VS[i * 256 + j * 128 + col]) * BETA[j * 64 + i];
      } else {
#pragma unroll
          for (int i = 0; i < 64; ++i) xp[i >> 1][i & 1] = bf2f(KS[i * QSTR + (col - 128)]) * BETA[j * 64 + i] * EGC[j * 64 + i];
      }
      { TRow8 r1; load_trow8<1>(r1, T); solve_rows<1>(xp, T, r1); }
      if (col < 128) { bf16_t* dst = UT + (size_t)(n * 32 + hv) * 8192 + (((col >> 4) * 4) * 64 + (col & 15)) * 4;
#pragma unroll
          for (int q4 = 0; q4 < 16; ++q4) { u32x2 p; p.x = cvtpk(xp[2 * q4][0], xp[2 * q4][1]); p.y = cvtpk(xp[2 * q4 + 1][0], xp[2 * q4 + 1][1]);
              *(u32x2*)(dst + ((q4 >> 2) * 64 + 16 * (q4 & 3)) * 4) = p; } }
      else { const int d = col - 128; bf16_t* dst = NWB + (size_t)(n * 32 + hv) * 8192 + ((d >> 5) * 64 + 16 * ((d & 31) >> 3)) * 8 + (d & 7);
#pragma unroll
          for (int i = 0; i < 64; ++i) { *dst = f2bf(-xp[i >> 1][i & 1]); dst += ((i & 15) == 15) ? (2048 - 15 * 8) : 8; asm volatile("" : "+v"(dst)); } } }
    __syncthreads();
}

constexpr int SSTR = 136, VSTR = 72;
constexpr int OFF_ST = 0, OFF_VN = OFF_ST + 16 * SSTR * 2, OFF_VSC = OFF_VN + 16 * VSTR * 2, LDS_SCAN = OFF_VSC + 16 * VSTR * 2;
__device__ __forceinline__ void scan_item(int hv, int cb, const bf16_t* __restrict__ QN, const bf16_t* __restrict__ KT, const bf16_t* __restrict__ UT, const bf16_t* __restrict__ NWB, const bf16_t* __restrict__ INTRA,
                                          const float* __restrict__ GCG, bf16_t* __restrict__ OG, LAS unsigned char* lds, int wv) {
    const int tid = tidw(wv), w = wv, lane = tid & 63, g4 = lane >> 4, l15 = lane & 15, wq = w & 3, hk = hv >> 1;
    LAS bf16_t* ST = (LAS bf16_t*)(lds + OFF_ST); LAS bf16_t* VN = (LAS bf16_t*)(lds + OFF_VN); LAS bf16_t* VSC = (LAS bf16_t*)(lds + OFF_VSC);
    for (int i = tid; i < 16 * SSTR / 2; i += NTHREADS) ((LAS unsigned*)ST)[i] = 0u;
    f32x4 Sacc = {0.f, 0.f, 0.f, 0.f};
    __syncthreads();
    struct Ops { bf16x8 a1[4]; bf16x8 ax[4]; u32x2 u; f32x4 gc; float gl; };
    const bf16_t* p1base = (w < 4) ? NWB + (size_t)hv * 8192 + (wq * 256 + lane) * 8 : QN + (size_t)hk * 8192 + (wq * 256 + lane) * 8;
    const size_t p1stride = (w < 4) ? (size_t)32 * 64 * 128 : (size_t)16 * 64 * 128;
    f32x4 Sacc1 = {0.f, 0.f, 0.f, 0.f};
    const bf16_t* pa1 = p1base;
    const bf16_t* pax = (w >= 4) ? INTRA + (size_t)hv * 4096 + (wq * 128 + lane) * 8 : KT + (size_t)hk * 8192 + (w * 128 + lane) * 8;
    const size_t axstride = (w >= 4) ? (size_t)32 * 64 * 64 : (size_t)16 * 128 * 64;
    const bf16_t* pu = UT + (size_t)hv * 8192 + ((cb * 4 + wq) * 64 + lane) * 4;
    const float* pgc = GCG + (size_t)hv * 64 + 16 * wq + 4 * g4;
    const float* pgl = GCG + (size_t)hv * 64 + 63;
    bf16_t* pog = OG + ((size_t)(hv * 8 + cb) * 64 + 16 * wq) * 16;
    LAS bf16_t* OT = (LAS bf16_t*)(lds + LDS_SCAN);
#define LOADOPS(O, n) do { \
      _Pragma("unroll") for (int s = 0; s < 4; ++s) O.a1[s] = *(const bf16x8*)(pa1 + 512 * s); \
      O.ax[0] = *(const bf16x8*)(pax); O.ax[1] = *(const bf16x8*)(pax + 512); \
      if (w < 4) { O.ax[2] = *(const bf16x8*)(pax + 4096); O.ax[3] = *(const bf16x8*)(pax + 4096 + 512); O.u = *(const u32x2*)(pu); } \
      O.gc = *(const f32x4*)(pgc); O.gl = *pgl; \
      pa1 += p1stride; pax += axstride; pu += 32 * 128 * 64; pgc += 32 * 64; pgl += 32 * 64; } while (0)
#define SCAN_STEP(O_, n) do { \
        f32x4 acc, acc2 = {0.f, 0.f, 0.f, 0.f}; \
        if (w < 4) acc = (f32x4){bflo(O_.u.x), bfhi(O_.u.x), bflo(O_.u.y), bfhi(O_.u.y)}; else acc = (f32x4){0.f, 0.f, 0.f, 0.f}; \
        { const bf16x8 b0 = *(LAS bf16x8*)(ST + l15 * SSTR + 8 * g4), b1 = *(LAS bf16x8*)(ST + l15 * SSTR + 32 + 8 * g4), b2 = *(LAS bf16x8*)(ST + l15 * SSTR + 64 + 8 * g4), b3 = *(LAS bf16x8*)(ST + l15 * SSTR + 96 + 8 * g4); \
          acc = __builtin_amdgcn_mfma_f32_16x16x32_bf16(O_.a1[0], b0, acc, 0, 0, 0); acc2 = __builtin_amdgcn_mfma_f32_16x16x32_bf16(O_.a1[2], b2, acc2, 0, 0, 0); \
          acc = __builtin_amdgcn_mfma_f32_16x16x32_bf16(O_.a1[1], b1, acc, 0, 0, 0); acc2 = __builtin_amdgcn_mfma_f32_16x16x32_bf16(O_.a1[3], b3, acc2, 0, 0, 0); acc = acc + acc2; } \
        if (w < 4) { u32x2 p; p.x = cvtpk(acc[0], acc[1]); p.y = cvtpk(acc[2], acc[3]); *(LAS u32x2*)(VN + l15 * VSTR + 16 * wq + 4 * g4) = p; \
            const float e0 = __expf(O_.gl - O_.gc[0]), e1 = __expf(O_.gl - O_.gc[1]), e2 = __expf(O_.gl - O_.gc[2]), e3 = __expf(O_.gl - O_.gc[3]); \
            p.x = cvtpk(acc[0] * e0, acc[1] * e1); p.y = cvtpk(acc[2] * e2, acc[3] * e3); *(LAS u32x2*)(VSC + l15 * VSTR + 16 * wq + 4 * g4) = p; } \
        else { acc[0] *= __expf(O_.gc[0]); acc[1] *= __expf(O_.gc[1]); acc[2] *= __expf(O_.gc[2]); acc[3] *= __expf(O_.gc[3]); } \
        __syncthreads(); \
        if (w >= 4) { \
            _Pragma("unroll") \
            for (int s = 0; s < 2; ++s) { const bf16x8 b = *(LAS bf16x8*)(VN + l15 * VSTR + 32 * s + 8 * g4); acc = __builtin_amdgcn_mfma_f32_16x16x32_bf16(O_.ax[s], b, acc, 0, 0, 0); } \
            { LAS bf16_t* ot = OT + (w - 4) * 256;        \
              _Pragma("unroll") \
              for (int r = 0; r < 4; ++r) ot[(4 * g4 + r) * 16 + l15] = f2bf(acc[r]); \
              asm volatile("s_waitcnt lgkmcnt(0)" ::: "memory"); \
              if (lane < 32) *(u32x4*)(pog + lane * 8) = *(LAS u32x4*)(ot + lane * 8); } } \
        else { const float eg = __expf(O_.gl); Sacc = Sacc * eg; Sacc1 = Sacc1 * eg; \
            const bf16x8 b0 = *(LAS bf16x8*)(VSC + l15 * VSTR + 8 * g4), b1 = *(LAS bf16x8*)(VSC + l15 * VSTR + 32 + 8 * g4); \
            Sacc = __builtin_amdgcn_mfma_f32_16x16x32_bf16(O_.ax[0], b0, Sacc, 0, 0, 0); Sacc1 = __builtin_amdgcn_mfma_f32_16x16x32_bf16(O_.ax[2], b0, Sacc1, 0, 0, 0); \
            Sacc = __builtin_amdgcn_mfma_f32_16x16x32_bf16(O_.ax[1], b1, Sacc, 0, 0, 0); Sacc1 = __builtin_amdgcn_mfma_f32_16x16x32_bf16(O_.ax[3], b1, Sacc1, 0, 0, 0); \
            u32x2 p; p.x = cvtpk(Sacc[0], Sacc[1]); p.y = cvtpk(Sacc[2], Sacc[3]); *(LAS u32x2*)(ST + l15 * SSTR + 16 * w + 4 * g4) = p; \
            p.x = cvtpk(Sacc1[0], Sacc1[1]); p.y = cvtpk(Sacc1[2], Sacc1[3]); *(LAS u32x2*)(ST + l15 * SSTR + 16 * (w + 4) + 4 * g4) = p; } \
        pog += 32 * 8 * 64 * 16; __syncthreads(); \
    } while (0)
    Ops ring[4];
    LOADOPS(ring[0], 0); LOADOPS(ring[1], 1); LOADOPS(ring[2], 2);
    for (int nb = 0; nb < 128; nb += 4) {
#pragma unroll
        for (int k = 0; k < 4; ++k) { const int n = nb + k; LOADOPS(ring[(k + 3) % 4], n + 3); SCAN_STEP(ring[k], n); }
    }
#undef SCAN_STEP
#undef LOADOPS
}
}

constexpr size_t MiB = 1u << 20;
constexpr size_t WS_WIN = 0, WS_WOUT = 50 * MiB, WS_WGU = 66 * MiB, WS_WD = 110 * MiB;
constexpr size_t WS_H = 132 * MiB, WS_XN = 196 * MiB, WS_PROJ = 228 * MiB, WS_Z = 356 * MiB, WS_MIX = 420 * MiB;
constexpr size_t WS_G1 = 484 * MiB, WS_G2 = 548 * MiB, WS_G3 = 612 * MiB, WS_G4 = 644 * MiB, WS_G5 = 676 * MiB, WS_SM = 708 * MiB, WS_XF = 716 * MiB, WS_END = 732 * MiB;
constexpr size_t WS_CTL = WS_SM + 4 * MiB;
constexpr size_t XSLAB = (size_t)M * 64;
constexpr int LDS_BYTES = 147456;

#ifndef EN_MIX
#define EN_MIX 7
#endif
#ifndef EN_FFN
#define EN_FFN 1
#endif
struct Args { const float* in[25]; float* out; unsigned char* ws; };

typedef __attribute__((address_space(4))) const unsigned char* kargp_t;
__device__ __forceinline__ const float* kin(int i) {
    kargp_t kp = (kargp_t)__builtin_amdgcn_kernarg_segment_ptr(); asm volatile("" : "+s"(kp));
    return (const float*)*(const __attribute__((address_space(1))) float* const __attribute__((address_space(4)))*)(kp + 8 * i);
}
__global__ void __launch_bounds__(NTHREADS) mega_fwd(Args args) {
    extern __shared__ __attribute__((aligned(16))) unsigned char lds[];
    cg::grid_group grid = cg::this_grid();
    LAS unsigned char* L = (LAS unsigned char*)lds;
#define G opq_i((int)gridDim.x)
#define bid opq_i((int)blockIdx.x)
    const int WV = __builtin_amdgcn_readfirstlane((int)threadIdx.x >> 6);
    { volatile LAS unsigned* st = (volatile LAS unsigned*)(L + LDS_BYTES - 16); if (threadIdx.x < 4) st[threadIdx.x] = 0u; __syncthreads();
      (void)xcd_barrier_post((unsigned*)(args.ws + WS_CTL), st); }
#define GSYNC() do { XcdBarrier b_; b_.bar = (unsigned*)WSP(WS_CTL); b_.x = xb_xcc_id(); b_.st = (volatile LAS unsigned*)(L + LDS_BYTES - 16); xcd_barrier(b_); } while (0)
    unsigned char* ws0 = args.ws;
#define PV const int tid = tidw(WV), lane = tid & 63, wave = WV; const int gw = bid * NWAVES + wave, ngw = G * NWAVES; LAS float* scr = (LAS float*)(L + wave * 16640); (void)lane; (void)gw; (void)ngw; (void)scr;
#define VCU ((G % 8 == 0) ? (bid % 8) * (G / 8) + bid / 8 : bid)
#define WSP(off) (ws0 + opq((size_t)(off)))
#define Win ((bf16_t*)WSP(WS_WIN))
#define Wout ((bf16_t*)WSP(WS_WOUT))
#define Wgu ((bf16_t*)WSP(WS_WGU))
#define Wd ((bf16_t*)WSP(WS_WD))
#define H ((bf16_t*)WSP(WS_H))
#define XN ((bf16_t*)WSP(WS_XN))
#define PROJ ((bf16_t*)WSP(WS_PROJ))
#define ZB ((bf16_t*)WSP(WS_Z))
#define MIX ((bf16_t*)WSP(WS_MIX))
#define OM0 ((float*)WSP(WS_G1))
#define OM1 ((float*)WSP(WS_G2))
#define UT ((bf16_t*)WSP(WS_G1))
#define NWB ((bf16_t*)WSP(WS_G2))
#define QN ((bf16_t*)WSP(WS_G3))
#define KT ((bf16_t*)WSP(WS_G4))
#define INTRA ((bf16_t*)WSP(WS_G5))
#define XF ((float*)WSP(WS_XF))
#define RSS ((float*)WSP(WS_SM))
#define RT_ ((const LAS float*)(L + pg8::RT_OFF))
#define NCK ((float*)WSP(WS_SM + 2 * MiB))
#define GCG ((float*)WSP(WS_SM + 3 * MiB))

    if (args.out == nullptr) grid.sync();
#pragma unroll 1
    for (int layer = 0; layer < 4; ++layer) {
        const int kind = layer % 3, slot = layer / 3;
        { PV
            if (kind == 0) { cvt_matrix(kin(4) + (size_t)slot * 2048 * 6144, 6144, 0, 6144, 2048, Win, 0, 0, scr, gw, ngw, lane, kin(1) + layer * DM);
                             cvt_matrix(kin(5) + (size_t)slot * 2048 * 2048, 2048, 0, 2048, 2048, Wout, 0, 0, scr, gw, ngw, lane); }
            else if (kind == 1) { cvt_matrix(kin(11), 8208, 0, 8208, 2048, Win, 0, 0, scr, gw, ngw, lane, kin(1) + layer * DM);
                                  cvt_matrix(kin(12), 2048, 0, 2048, 2048, Wout, 0, 0, scr, gw, ngw, lane); }
            else { cvt_matrix(kin(16), 12352, 0, 12352, 2048, Win, 0, 0, scr, gw, ngw, lane, kin(1) + layer * DM);
                   cvt_matrix(kin(17), 2048, 0, 2048, 4096, Wout, 0, 0, scr, gw, ngw, lane); }
            cvt_matrix(kin(22) + (size_t)layer * 2048 * FF, FF, 0, FF, 2048, Wgu, 1, 0, scr, gw, ngw, lane, kin(2) + layer * DM);
            cvt_matrix(kin(23) + (size_t)layer * 2048 * FF, FF, 0, FF, 2048, Wgu, 2, 0, scr, gw, ngw, lane, kin(2) + layer * DM);
            cvt_matrix(kin(24) + (size_t)layer * FF * 2048, 2048, 0, 2048, FF, Wd, 0, 0, scr, gw, ngw, lane);
            if (layer == 0) prologue_rows(kin(0), XN, RSS, gw, ngw, lane);
        }
        GSYNC();
        if ((EN_MIX >> kind) & 1) {
        {
            const int N = kind == 0 ? 6144 : kind == 1 ? 8192 : 12288;
            const bf16_t* Ain = layer == 0 ? (const bf16_t*)XN : (const bf16_t*)H;
            pg8::Gemm g{Ain, Win, M, N, DM, DM / 64}; pg8::StaticOrder S; S.init(M, N, G, bid);
            pg8::build_rinv_table(L, S, RSS, tidw(WV));
            pg8::EpiStore E;
            if (kind == 0) E = pg8::EpiStore{PROJ, 6144, PROJ, 6144, 1 << 30, XF, 16, 1 << 30, 2048, QSCALE, RT_};
            else if (kind == 1) E = pg8::EpiStore{PROJ, 8192, PROJ, 8192, 1 << 30, XF, 16, 1 << 30, 0, 1.f, RT_};
            else E = pg8::EpiStore{PROJ, 8192, ZB, 4096, 8192, XF, 64, 1 << 30, 0, 1.f, RT_};
            pg8::gemm_phase<pg8::EpiStore, pg8::StaticOrder, true, true>(L, g, S, E, WV);
            if (kind != 0) {
                pg8::Gemm g2{Ain, Win, M, N + 256, DM, 4}; pg8::SplitKOrder S2; S2.init(M, 8, N / 256, G, bid);
                pg8::build_rinv_table(L, S2, RSS, tidw(WV));
                pg8::EpiXF E2{XF, kind == 1 ? 16 : 64, XSLAB, kind == 1 ? 1 : 0, RT_};
                pg8::gemm_phase<pg8::EpiXF, pg8::SplitKOrder, true, true>(L, g2, S2, E2, WV);
            }
        }
        GSYNC();
        if (kind == 0) { {
            for (int idx = VCU; idx < 1024; idx += G) { const int v = idx & 255, i = idx >> 8, vh = v >> 3, s = v & 7; const int qb = i == 0 ? s : i == 1 ? 15 - s : i == 2 ? 16 + s : 31 - s;
                const int mp = vh >> 4, hd = (vh >> 1) & 7, vhalf = vh & 1;
                const bf16_t* Qb = PROJ + (size_t)(256 * qb) * 6144 + mp * 1024 + hd * 128; const bf16_t* Kh = PROJ + 2048 + mp * 1024 + hd * 128; const bf16_t* Vh = PROJ + 4096 + hd * 256 + vhalf * 128;
                float* Of = (mp ? OM1 : OM0) + (size_t)(256 * qb) * 2048 + hd * 256 + vhalf * 128;
                att::attn_unit<0, 6144, 2>(Qb, Kh, Vh, qb, nullptr, Of, nullptr, nullptr, (char*)lds, WV); } }
            GSYNC();
            PV
            diff_combine(OM0, OM1, kin(6) + slot * 128, kin(7) + slot * 128, kin(8) + slot * 128, kin(9) + slot * 128, kin(10) + slot * 256,
                         0.8f - 0.6f * expf(-0.3f * (float)layer), MIX, gw, ngw, lane);
        } else if (kind == 1) { { PV
            fox_qknorm(PROJ, kin(14), kin(15), gw, ngw, lane);
            for (int hd = bid; hd < 16; hd += G) fox_cumsum(XF, kin(13), NCK, hd, (LAS float*)L, tid); }
            GSYNC();
            for (int idx = VCU; idx < 512; idx += G) { const int v = idx & 255, i = idx >> 8, hd = v >> 4, s = v & 15; const int qb = i == 0 ? s : 31 - s;
                const bf16_t* Qb = PROJ + (size_t)(256 * qb) * 8192 + hd * 128; const bf16_t* Kh = PROJ + 2048 + hd * 128; const bf16_t* Vh = PROJ + 4096 + hd * 128;
                att::attn_unit<1, 8192, 1>(Qb, Kh, Vh, qb, NCK + (size_t)hd * M, nullptr, MIX + (size_t)(256 * qb) * 2048 + hd * 128, PROJ + (size_t)(256 * qb) * 8192 + 6144 + hd * 128, (char*)lds, WV); }
        } else {
            for (int u = bid; u < 2048; u += G) gdn::prep_unit(u & 15, u >> 4, PROJ, XF, kin(18), kin(19), kin(20), QN, KT, UT, NWB, INTRA, GCG, L, WV);
            GSYNC();
            for (int wi = bid; wi < 256; wi += G) gdn::scan_item(wi & 31, wi >> 5, QN, KT, UT, NWB, INTRA, GCG, PROJ  , L, WV);
            GSYNC();
            PV
            gdn_post(PROJ, ZB, kin(21), MIX, gw, ngw, lane);
        }
        GSYNC();
        {
            const int K = kind == 2 ? 4096 : 2048;
            pg8::Gemm g{MIX, Wout, M, DM, K, K / 64}; pg8::StaticOrder S; S.init(M, DM, G, bid);
            pg8::EpiRes E{layer == 0 ? kin(0) : (const float*)nullptr, H, H, DM, RSS};
            pg8::gemm_phase<pg8::EpiRes, pg8::StaticOrder, true, true>(L, g, S, E, WV);
        }
        GSYNC();
        }
        if (EN_FFN) {
        {
            pg8::Gemm g{H, Wgu, M, 2 * FF, DM, DM / 64}; pg8::StaticOrder S; S.init(M, 2 * FF, G, bid);
            pg8::build_rinv_table(L, S, RSS, tidw(WV));
            pg8::EpiSwiglu E{PROJ, FF, RT_};
            pg8::gemm_phase<pg8::EpiSwiglu, pg8::StaticOrder, true, true>(L, g, S, E, WV);
        }
        GSYNC();
        {
            pg8::Gemm g{PROJ, Wd, M, DM, FF, FF / 64}; pg8::StaticOrder S; S.init(M, DM, G, bid);
            pg8::EpiRes E{nullptr, H, H, DM, RSS};
            pg8::gemm_phase<pg8::EpiRes, pg8::StaticOrder, true, true>(L, g, S, E, WV);
        }
        GSYNC();
        }
    }
    { PV norm_rows_b<true, 2>(H, kin(3), nullptr, args.out, gw, ngw, lane); }
}

extern "C" void kernel_launch(void* const* d_in, const int* in_sizes, int n_in, void* d_out, int out_size, void* d_ws, size_t ws_size, hipStream_t stream) {
    static int grid_blocks = 0;
    if (grid_blocks == 0) {
        if (n_in != 25 || out_size != M * DM || ws_size < WS_END) { fprintf(stderr, "kernel_launch: unexpected shapes (n_in %d, out %d, ws %zu)\n", n_in, out_size, ws_size); grid_blocks = -1; return; }
        int dev = 0, cus = 0, per_cu = 0;
        hipGetDevice(&dev); hipDeviceGetAttribute(&cus, hipDeviceAttributeMultiprocessorCount, dev);
        hipFuncSetAttribute((const void*)mega_fwd, hipFuncAttributeMaxDynamicSharedMemorySize, LDS_BYTES);
        hipOccupancyMaxActiveBlocksPerMultiprocessor(&per_cu, (const void*)mega_fwd, NTHREADS, LDS_BYTES);
        if (per_cu < 1) per_cu = 1;
        grid_blocks = cus * 1;
        (void)hipGetLastError();
    }
    if (grid_blocks < 0) return;
    if (hipMemsetAsync((char*)d_ws + WS_CTL, 0, 16384, stream) != hipSuccess) { fprintf(stderr, "kernel_launch: memset failed\n"); return; }
    Args a{};
    for (int i = 0; i < 25; ++i) a.in[i] = (const float*)d_in[i];
    a.out = (float*)d_out; a.ws = (unsigned char*)d_ws;
    void* kargs[] = {&a};
    hipError_t e = hipLaunchCooperativeKernel((const void*)mega_fwd, dim3(grid_blocks), dim3(NTHREADS), kargs, LDS_BYTES, stream);
    if (e != hipSuccess) fprintf(stderr, "cooperative launch failed: %s (grid %d)\n", hipGetErrorString(e), grid_blocks);
}
```
